# Optimizing an MI355X kernel written in HIP

```python
import math
import jax
import jax.numpy as jnp
from jax import lax
import numpy as np

D_MODEL = 1024
BATCH = 8
SEQ = 2048
DEPTH = 2

GRID_W = 64
CTX_LEN = 256
HEAD_DIM = 64
MIX_WIDTH = 1024
N_MOD = 9
FFN_HIDDEN = 2816
NORM_EPS = 1e-6
FOURIER_GROUPS = 4
FOURIER_WIDTH = FOURIER_GROUPS * HEAD_DIM
GLA_HEADS = 6
GLA_DK = 64
GLA_DV = 128
GLA_GATE_RANK = 16
GLA_TAU = 16.0
GLA_CHUNK = 64
CONV_GROUPS = 4
CONV_WIDTH = CONV_GROUPS * HEAD_DIM
CONV_TAPS = 3
DIFF_HEADS = 6
DIFF_DV = 2 * HEAD_DIM
Q_BLOCK = 128
ROPE_THETA = 10000.0
ROPE_AXIS_DIM = HEAD_DIM // 2
N_EVEN = (DEPTH + 1) // 2
N_ODD = DEPTH // 2
EVEN_SPLITS = (FOURIER_WIDTH, GLA_HEADS * GLA_DK, GLA_HEADS * GLA_DK, GLA_HEADS * GLA_DV, GLA_HEADS * GLA_DV, GLA_GATE_RANK, GLA_GATE_RANK)
EVEN_IN = sum(EVEN_SPLITS)
ODD_SPLITS = (CONV_WIDTH, CONV_WIDTH, CONV_WIDTH, DIFF_HEADS * 2 * HEAD_DIM, DIFF_HEADS * 2 * HEAD_DIM, DIFF_HEADS * DIFF_DV)
ODD_IN = sum(ODD_SPLITS)

kernel_name = 'hybrid_fnet_gla_shortconv_diffattn_prefix_dit'


def _split(z, sizes):
    idx = [int(i) for i in np.cumsum(sizes)[:-1]]
    return jnp.split(z, idx, axis=-1)


def _rmsnorm(x, g):
    xf = x.astype(jnp.float32)
    y = xf * lax.rsqrt(jnp.mean(xf * xf, axis=-1, keepdims=True) + NORM_EPS)
    return (y * g.astype(jnp.float32)).astype(x.dtype)


def _modulation(cond, w, b):
    m = jax.nn.silu(cond) @ w + b
    return jnp.split(m[..., None, :], N_MOD, axis=-1)


def _prenorm(h, gain, shift, scale):
    return _rmsnorm(h, gain) * (1.0 + scale) + shift


def _swiglu(h, w_in, w_out):
    g, u = jnp.split(h @ w_in, 2, axis=-1)
    return (jax.nn.silu(g) * u) @ w_out


def _axial_rope_tables(rows):
    row = jnp.repeat(jnp.arange(rows), GRID_W).astype(jnp.float32)
    col = jnp.tile(jnp.arange(GRID_W), rows).astype(jnp.float32)
    n = ROPE_AXIS_DIM // 2
    inv = ROPE_THETA ** (-jnp.arange(n, dtype=jnp.float32) / n)
    ang = jnp.concatenate([row[:, None] * inv, col[:, None] * inv], axis=-1)
    return jnp.cos(ang), jnp.sin(ang)


def _axial_rope(x, cos, sin):
    n = ROPE_AXIS_DIM // 2
    def rot(part, cs, sn):
        p1, p2 = jnp.split(part, 2, axis=-1)
        return jnp.concatenate([p1 * cs - p2 * sn, p1 * sn + p2 * cs], axis=-1)
    bc = lambda t: t[:, None, None, :]
    xr = rot(x[..., :ROPE_AXIS_DIM], bc(cos[:, :n]), bc(sin[:, :n]))
    xc = rot(x[..., ROPE_AXIS_DIM:], bc(cos[:, n:]), bc(sin[:, n:]))
    return jnp.concatenate([xr, xc], axis=-1).astype(x.dtype)


def _fourier_mix(z):
    bn, t, _ = z.shape
    zf = z.astype(jnp.float32).reshape(bn, t, FOURIER_GROUPS, HEAD_DIM)
    y = jnp.fft.fft2(zf, axes=(1, 3), norm='ortho').real
    return y.reshape(bn, t, FOURIER_WIDTH).astype(z.dtype)


def _gla_chunked(q, k, v, logg, s0):
    bn, h, t, dk = q.shape
    dv = v.shape[-1]
    n = t // GLA_CHUNK
    def chunks(a):
        return jnp.moveaxis(a.reshape(bn, h, n, GLA_CHUNK, a.shape[-1]), 2, 0)
    b = jnp.cumsum(chunks(logg), axis=-2)
    mask = jnp.tril(jnp.ones((GLA_CHUNK, GLA_CHUNK), dtype=bool))
    def step(s, inp):
        qc, kc, vc, bc = inp
        bl = bc[..., -1:, :]
        qd = qc * jnp.exp(bc)
        kd = kc * jnp.exp(-bc)
        att = jnp.where(mask, jnp.einsum('bhid,bhjd->bhij', qd, kd), 0.0)
        o = jnp.einsum('bhid,bhdv->bhiv', qd, s) + jnp.einsum('bhij,bhjv->bhiv', att, vc)
        s = s * jnp.exp(bl)[..., 0, :, None] + jnp.einsum('bhjd,bhjv->bhdv', kc * jnp.exp(bl - bc), vc)
        return s, o
    s, o = lax.scan(step, s0, (chunks(q), chunks(k), chunks(v), b))
    return jnp.moveaxis(o, 0, 2).reshape(bn, h, t, dv), s


def _even_mixer(z, s0_f, s0_b, gate_w, gate_b, gla_g):
    bn, t, _ = z.shape
    z_f, zq, zk, zv, zr, zgf, zgb = _split(z, EVEN_SPLITS)
    y_f = _fourier_mix(z_f)
    def heads(a, d):
        return a.astype(jnp.float32).reshape(bn, t, GLA_HEADS, d).transpose(0, 2, 1, 3)
    q = heads(zq, GLA_DK) * (GLA_DK ** -0.5)
    k = heads(zk, GLA_DK)
    v = heads(zv, GLA_DV)
    gw = gate_w.astype(jnp.float32)
    gb = gate_b.astype(jnp.float32)
    logg_f = heads(jax.nn.log_sigmoid(zgf.astype(jnp.float32) @ gw[0] + gb[0]), GLA_DK) / GLA_TAU
    logg_b = heads(jax.nn.log_sigmoid(zgb.astype(jnp.float32) @ gw[1] + gb[1]), GLA_DK) / GLA_TAU
    flip = lambda a: jnp.flip(a, axis=2)
    o_f, s_f = _gla_chunked(q, k, v, logg_f, s0_f)
    o_b, s_b = _gla_chunked(flip(q), flip(k), flip(v), flip(logg_b), s0_b)
    o = (o_f + flip(o_b)).transpose(0, 2, 1, 3)
    o = _rmsnorm(o, gla_g) * jax.nn.silu(zr.astype(jnp.float32).reshape(bn, t, GLA_HEADS, GLA_DV))
    y_g = o.reshape(bn, t, GLA_HEADS * GLA_DV).astype(z.dtype)
    return jnp.concatenate([y_f, y_g], axis=-1), s_f, s_b


def _short_conv(zb, zc, zx, w, b):
    u = zc * zx
    t = u.shape[1]
    up = jnp.pad(u, ((0, 0), (1, 1), (0, 0)))
    y = up[:, 0:t] * w[0] + up[:, 1:t + 1] * w[1] + up[:, 2:t + 2] * w[2] + b
    return zb * y


def _odd_parts(z):
    bn, t, _ = z.shape
    zb, zc, zx, q, k, v = _split(z, ODD_SPLITS)
    q = q.reshape(bn, t, DIFF_HEADS, 2, HEAD_DIM)
    k = k.reshape(bn, t, DIFF_HEADS, 2, HEAD_DIM)
    v = v.reshape(bn, t, DIFF_HEADS, DIFF_DV)
    return zb, zc, zx, q, k, v


def _diff_attn(q, k, v, lam):
    s = jnp.einsum('bqhsd,bkhsd->bhsqk', q, k, preferred_element_type=jnp.float32) * (HEAD_DIM ** -0.5)
    p = jax.nn.softmax(s, axis=-1)
    a = p[:, :, 0] - lam * p[:, :, 1]
    return jnp.einsum('bhqk,bkhv->bqhv', a, v.astype(jnp.float32))


def _diff_attn_blocked(q, k, v, lam):
    bn, t = q.shape[:2]
    nb = t // Q_BLOCK
    qb = jnp.moveaxis(q.reshape(bn, nb, Q_BLOCK, DIFF_HEADS, 2, HEAD_DIM), 1, 0)
    o = lax.map(lambda blk: _diff_attn(blk, k, v, lam), qb)
    return jnp.moveaxis(o, 0, 1).reshape(bn, t, DIFF_HEADS, DIFF_DV)


def _subln(o, g, lam_init, dtype):
    bn, t = o.shape[:2]
    return (_rmsnorm(o, g) * (1.0 - lam_init)).reshape(bn, t, DIFF_HEADS * DIFF_DV).astype(dtype)


def _odd_mixer(zl, zc, cos, sin, conv_w, conv_b, lam, lam_init, dnorm, with_ctx_out):
    lat = _odd_parts(zl)
    cx = _odd_parts(zc)
    ql = _axial_rope(lat[3], cos, sin)
    kl = _axial_rope(lat[4], cos, sin)
    k_all = jnp.concatenate([kl, cx[4]], axis=1)
    v_all = jnp.concatenate([lat[5], cx[5]], axis=1)
    att_l = _diff_attn_blocked(ql, k_all, v_all, lam)
    y_l = jnp.concatenate([_short_conv(lat[0], lat[1], lat[2], conv_w, conv_b),
                           _subln(att_l, dnorm, lam_init, zl.dtype)], axis=-1)
    if not with_ctx_out:
        return y_l, None
    att_c = _diff_attn(cx[3], cx[4], cx[5], lam)
    y_c = jnp.concatenate([_short_conv(cx[0], cx[1], cx[2], conv_w, conv_b),
                           _subln(att_c, dnorm, lam_init, zc.dtype)], axis=-1)
    return y_l, y_c


def setup_inputs(seed: int = 0) -> dict:
    key = jax.random.key(seed)
    ks = jax.random.split(key, 28)
    nrm = lambda k, shape, s: jax.random.normal(k, shape, jnp.float32) * s
    gain = lambda k, shape: 1.0 + 0.05 * jax.random.normal(k, shape, jnp.float32)
    D = D_MODEL
    return {
        'x': nrm(ks[0], (BATCH, SEQ, D), 1.0),
        'c': nrm(ks[1], (BATCH, D), 1.0),
        'ctx': nrm(ks[2], (BATCH, CTX_LEN, D), 1.0),
        'c_ctx': nrm(ks[3], (D,), 1.0),
        'ada_w': nrm(ks[4], (DEPTH, D, N_MOD * D), 0.5 * D ** -0.5),
        'ada_b': nrm(ks[5], (DEPTH, N_MOD * D), 0.01),
        'norm_ffn1': gain(ks[6], (DEPTH, D)),
        'norm_mix': gain(ks[7], (DEPTH, D)),
        'norm_ffn2': gain(ks[8], (DEPTH, D)),
        'ffn1_w_in': nrm(ks[9], (DEPTH, D, 2 * FFN_HIDDEN), D ** -0.5),
        'ffn1_w_out': nrm(ks[10], (DEPTH, FFN_HIDDEN, D), FFN_HIDDEN ** -0.5),
        'ffn2_w_in': nrm(ks[11], (DEPTH, D, 2 * FFN_HIDDEN), D ** -0.5),
        'ffn2_w_out': nrm(ks[12], (DEPTH, FFN_HIDDEN, D), FFN_HIDDEN ** -0.5),
        'mix_w_out': nrm(ks[13], (DEPTH, MIX_WIDTH, D), MIX_WIDTH ** -0.5),
        'even_w_in': nrm(ks[14], (N_EVEN, D, EVEN_IN), D ** -0.5),
        'gla_gate_w': nrm(ks[15], (N_EVEN, 2, GLA_GATE_RANK, GLA_HEADS * GLA_DK), GLA_GATE_RANK ** -0.5),
        'gla_gate_b': nrm(ks[16], (N_EVEN, 2, GLA_HEADS * GLA_DK), 0.1),
        'gla_norm': gain(ks[17], (N_EVEN, GLA_DV)),
        'odd_w_in': nrm(ks[18], (N_ODD, D, ODD_IN), D ** -0.5),
        'conv_w': nrm(ks[19], (N_ODD, CONV_TAPS, CONV_WIDTH), CONV_TAPS ** -0.5),
        'conv_b': nrm(ks[20], (N_ODD, CONV_WIDTH), 0.01),
        'lambda_q1': nrm(ks[21], (N_ODD, HEAD_DIM), 0.1),
        'lambda_k1': nrm(ks[22], (N_ODD, HEAD_DIM), 0.1),
        'lambda_q2': nrm(ks[23], (N_ODD, HEAD_DIM), 0.1),
        'lambda_k2': nrm(ks[24], (N_ODD, HEAD_DIM), 0.1),
        'diff_norm': gain(ks[25], (N_ODD, DIFF_DV)),
        'final_norm': gain(ks[26], (D,)),
    }


def reference(x, c, ctx, c_ctx, ada_w, ada_b, norm_ffn1, norm_mix, norm_ffn2, ffn1_w_in, ffn1_w_out,
              ffn2_w_in, ffn2_w_out, mix_w_out, even_w_in, gla_gate_w, gla_gate_b, gla_norm, odd_w_in,
              conv_w, conv_b, lambda_q1, lambda_k1, lambda_q2, lambda_k2, diff_norm, final_norm):
    bn = x.shape[0]
    rows = x.shape[1] // GRID_W
    cos, sin = _axial_rope_tables(rows)
    h, hc = x, ctx
    for layer in range(DEPTH):
        last = layer == DEPTH - 1
        sh1, sc1, g1, shm, scm, gm, sh2, sc2, g2 = _modulation(c, ada_w[layer], ada_b[layer])
        csh1, csc1, cg1, cshm, cscm, cgm, csh2, csc2, cg2 = _modulation(c_ctx, ada_w[layer], ada_b[layer])
        h = h + 0.5 * g1 * _swiglu(_prenorm(h, norm_ffn1[layer], sh1, sc1), ffn1_w_in[layer], ffn1_w_out[layer])
        hc = hc + 0.5 * cg1 * _swiglu(_prenorm(hc, norm_ffn1[layer], csh1, csc1), ffn1_w_in[layer], ffn1_w_out[layer])
        if layer % 2 == 0:
            i = layer // 2
            w_in = even_w_in[i]
            zl = _prenorm(h, norm_mix[layer], shm, scm) @ w_in
            zc = _prenorm(hc, norm_mix[layer], cshm, cscm) @ w_in
            s0 = jnp.zeros((bn, GLA_HEADS, GLA_DK, GLA_DV), jnp.float32)
            mix_c, s_f, s_b = _even_mixer(zc, s0, s0, gla_gate_w[i], gla_gate_b[i], gla_norm[i])
            mix_l, _, _ = _even_mixer(zl, s_f, s_b, gla_gate_w[i], gla_gate_b[i], gla_norm[i])
        else:
            i = layer // 2
            w_in = odd_w_in[i]
            zl = _prenorm(h, norm_mix[layer], shm, scm) @ w_in
            zc = _prenorm(hc, norm_mix[layer], cshm, cscm) @ w_in
            lam_init = 0.8 - 0.6 * math.exp(-0.3 * layer)
            lam = (jnp.exp(jnp.sum(lambda_q1[i].astype(jnp.float32) * lambda_k1[i].astype(jnp.float32)))
                   - jnp.exp(jnp.sum(lambda_q2[i].astype(jnp.float32) * lambda_k2[i].astype(jnp.float32)))
                   + lam_init)
            mix_l, mix_c = _odd_mixer(zl, zc, cos, sin, conv_w[i], conv_b[i], lam, lam_init, diff_norm[i],
                                      not last)
        h = h + gm * (mix_l @ mix_w_out[layer])
        h = h + 0.5 * g2 * _swiglu(_prenorm(h, norm_ffn2[layer], sh2, sc2), ffn2_w_in[layer], ffn2_w_out[layer])
        if not last:
            hc = hc + cgm * (mix_c @ mix_w_out[layer])
            hc = hc + 0.5 * cg2 * _swiglu(_prenorm(hc, norm_ffn2[layer], csh2, csc2), ffn2_w_in[layer], ffn2_w_out[layer])
    return _rmsnorm(h, final_norm)
```

```cpp
#include <hip/hip_runtime.h>
#include <hip/hip_cooperative_groups.h>
#include <cstdio>
#include <cstdint>
namespace cg = cooperative_groups;

#define LAS __attribute__((address_space(3)))
typedef unsigned short bf16_t;
typedef short bf16x8 __attribute__((ext_vector_type(8)));
typedef short s16x4 __attribute__((ext_vector_type(4)));
typedef float f32x4 __attribute__((ext_vector_type(4)));
typedef float f32x16 __attribute__((ext_vector_type(16)));
typedef unsigned u32x4 __attribute__((ext_vector_type(4)));
typedef unsigned u32x2 __attribute__((ext_vector_type(2)));

constexpr int D = 1024, NB = 8, TL = 2048, TC = 256, NLAT = NB * TL, NCTX = NB * TC, NROW = NLAT + NCTX;
constexpr int FF = 2816, NMOD = 9;
constexpr int EV_LD = 1792, OD_LD = 2304, KVT = TL + TC;
constexpr float EPS = 1e-6f;
constexpr float LAM_INIT = 0.35550906759f;
constexpr float QSCALE = 0.125f * 1.4426950408889634f;

constexpr size_t MiB = 1u << 20;
constexpr size_t WS_MOD = 0;
constexpr size_t WS_BAR = 768 * 1024;
constexpr size_t WS_ROPE = 1 * MiB;
constexpr size_t WS_CSC = 1 * MiB + 512 * 1024;
constexpr size_t WS_HC = 2 * MiB;
constexpr size_t WS_W0 = 10 * MiB;
constexpr size_t W_F1I = 0, W_F1O = 11 * MiB, W_F2I = 16 * MiB + 512 * 1024, W_F2O = 27 * MiB + 512 * 1024, W_MO = 33 * MiB, W_LAYER = 35 * MiB;
constexpr size_t WS_CS = WS_W0;
constexpr size_t WS_WEV = 80 * MiB;
constexpr size_t WS_WEVV = WS_WEV + 3 * MiB + 512 * 1024;
constexpr size_t WS_WPQ = 85 * MiB;
constexpr size_t WS_WOD = 86 * MiB;
constexpr size_t WS_WODV = WS_WOD + 4 * MiB + 512 * 1024;
constexpr size_t WS_A = 92 * MiB;
constexpr size_t WS_ACT = 128 * MiB;
constexpr size_t WS_OF = 191 * MiB;
constexpr size_t WS_FP1 = 218 * MiB;
constexpr size_t WS_VT = 227 * MiB;
constexpr size_t WS_PQT = 254 * MiB;
constexpr size_t WS_PQTC = 270 * MiB;
constexpr size_t WS_OB = 272 * MiB;
constexpr size_t WS_PART = 227 * MiB;
constexpr size_t WS_XCNT = 800 * 1024;
constexpr size_t WS_XBUF = 299 * MiB;
constexpr size_t WS_A2 = 227 * MiB;
constexpr size_t WS_END = 300 * MiB;

constexpr int LDS_BYTES = 131072 + 1024;

struct Params {
    const float *x, *c, *ctx, *c_ctx, *ada_w, *ada_b, *norm_ffn1, *norm_mix, *norm_ffn2, *ffn1_w_in, *ffn1_w_out, *ffn2_w_in, *ffn2_w_out,
        *mix_w_out, *even_w_in, *gla_gate_w, *gla_gate_b, *gla_norm, *odd_w_in, *conv_w, *conv_b, *lq1, *lk1, *lq2, *lk2, *diff_norm, *final_norm;
    float* out; unsigned char* ws; int ph_lo, ph_hi;
};

typedef const __attribute__((address_space(4))) Params KParams;
typedef KParams& PRef;
__device__ __forceinline__ float bf2f(unsigned h) { return __uint_as_float(h << 16); }
typedef float f32x2_t __attribute__((ext_vector_type(2))); typedef __bf16 bf16x2_t __attribute__((ext_vector_type(2)));
__device__ __forceinline__ unsigned cvt_pk_bf16(float lo, float hi) { f32x2_t v = {lo, hi}; bf16x2_t b = __builtin_convertvector(v, bf16x2_t); return __builtin_bit_cast(unsigned, b); }
__device__ __forceinline__ unsigned f2bf(float f) { return cvt_pk_bf16(f, 0.f) & 0xffffu; }
__device__ __forceinline__ unsigned pk2(float lo, float hi) { return cvt_pk_bf16(lo, hi); }
__device__ __forceinline__ float silu_f(float x) { return x / (1.0f + __expf(-x)); }
__device__ __forceinline__ float wave_sum(float v) {
#pragma unroll
    for (int o = 1; o < 64; o <<= 1) v += __shfl_xor(v, o);
    return v;
}
#define DPPF(x, ctrl, rm, bm) __int_as_float(__builtin_amdgcn_update_dpp(0, __float_as_int(x), ctrl, rm, bm, false))
#define MFMA16(a, b, c) __builtin_amdgcn_mfma_f32_16x16x32_bf16(a, b, c, 0, 0, 0)
#define MFMA32(a, b, c) __builtin_amdgcn_mfma_f32_32x32x16_bf16(a, b, c, 0, 0, 0)

namespace pg8 {
constexpr int BM = 256, BK = 64, HALF = 128, HTB = HALF * BK * 2, STAGE_BYTES = 8 * HTB;
__device__ __forceinline__ int lds_byte(int r, int c) { const int st = (r >> 4) * 2 + (c >> 5), rr = r & 15, cc = c & 31, ob = rr * 64 + cc * 2; return st * 1024 + (ob ^ (((ob >> 9) & 1) << 5)); }
__device__ __forceinline__ void stage_rc(int b, int& R, int& C) { const int st = b / 1024, sb = b % 1024, swz = sb ^ (((sb >> 9) & 1) << 5); R = (st >> 1) * 16 + swz / 64; C = (st & 1) * 32 + (swz % 64) / 2; }
__device__ __forceinline__ int perm32(int rho) { const int n = rho >> 4, i = rho & 15; return 8 * (i >> 2) + 4 * n + (i & 3); }

struct Unit { const char* a; const char* b; int pm, pn, tag, half; };
struct Seg { unsigned A, B, dims; };
__device__ __forceinline__ Seg mkseg(unsigned A, unsigned B, int nM, int nN, int pm0, int pn0, int tag) { Seg s; s.A = A; s.B = B; s.dims = (unsigned)nM | ((unsigned)nN << 8) | ((unsigned)pm0 << 16) | ((unsigned)pn0 << 24) | ((unsigned)tag << 28); return s; }
struct Sched {
    Seg s0, s1, s2; int G, vcu, coff; unsigned tstep; const char* ws;
    int nfull;
    int parts, kpart, kbase, pbase;
    __device__ __forceinline__ bool dec(const Seg& s, int& L, Unit& u) const {
        const int nM = s.dims & 255, nN = (s.dims >> 8) & 255;
        const int n = nM * nN;
        if (L < n) {
            const int idx = L, nig = 8 * nN, gid = idx / nig, fm = gid * 8, gsz = (nM - fm) < 8 ? (nM - fm) : 8;
            const int pm = fm + ((idx % nig) % gsz), pn = (idx % nig) / gsz;
            u.pm = (int)((s.dims >> 16) & 255) + pm; u.pn = (int)((s.dims >> 24) & 15) + pn; u.tag = (int)(s.dims >> 28); u.a = ws + s.A + (size_t)u.pm * tstep; u.b = ws + s.B + (size_t)u.pn * tstep; return true;
        }
        L -= n; return false;
    }
    __device__ __forceinline__ bool next(int i, Unit& u) const {
        int L = i * G + vcu - coff; if (L < 0) return false;
        u.half = 0; int hsel = -1;
        if (nfull > 0 && L >= nfull) { const int hl = L - nfull; hsel = hl & 1; L = nfull + (hl >> 1); }
        if (parts > 1) { const int part = L % parts; L /= parts; if (!dec(s0, L, u)) return false;
            const size_t ko = (size_t)(kbase + part * kpart) * 2; u.a += ko; u.b += ko; u.tag = pbase + part; return true; }
        if (!(dec(s0, L, u) || dec(s1, L, u) || dec(s2, L, u))) return false;
        if (hsel >= 0) { u.half = 1 + hsel; u.a += (size_t)hsel * (tstep >> 1); }
        return true;
    }
};

enum { T_SWIGLU = 0, T_ZEV = 1, T_ZODD = 2, T_TRV = 3, T_TRPQ = 4, T_FOUR = 5, T_FOURC = 6, T_FOUR2 = 7 };
struct EpiT {
    static constexpr bool PERM = true, AFTER_DRAIN = false;
    unsigned char* ws; unsigned dst_off; int ldc;
    __device__ __forceinline__ void operator()(const f32x4 (&acc)[2][2][4][2], const Unit& u, int wr, int wc, int fr, int fq) const {
        bf16_t* dst = (bf16_t*)(ws + dst_off); bf16_t* vt = (bf16_t*)(ws + WS_VT); bf16_t* pqt = (bf16_t*)(ws + WS_PQT); bf16_t* pqtc = (bf16_t*)(ws + WS_PQTC); const float* rope = (const float*)(ws + WS_ROPE);
        const int lr0 = wr * 64 + fr;
        const int lc0 = wc * 32 + 8 * fq;
        if (u.tag == T_SWIGLU) {
            const int rsh = (u.half == 2) ? HALF : 0;
#pragma unroll
            for (int ai = 0; ai < 2; ++ai)
#pragma unroll
                for (int m = 0; m < 4; ++m) {
                    if (ai == 1 && u.half != 0) continue;
                    bf16_t* rowp = dst + (size_t)(u.pm * BM + rsh + lr0 + ai * HALF + m * 16) * ldc + u.pn * HALF + lc0;
                    float o[8];
#pragma unroll
                    for (int n = 0; n < 2; ++n)
#pragma unroll
                        for (int e = 0; e < 4; e += 2) {
                            const f32x2_t g2 = (f32x2_t){acc[ai][0][m][n][e], acc[ai][0][m][n][e + 1]}, u2 = (f32x2_t){acc[ai][1][m][n][e], acc[ai][1][m][n][e + 1]};
                            const f32x2_t t2 = g2 * -1.4426950408889634f; const f32x2_t d2 = (f32x2_t){__builtin_amdgcn_exp2f(t2.x), __builtin_amdgcn_exp2f(t2.y)} + 1.0f;
                            const f32x2_t r2 = (g2 * u2) * (f32x2_t){__builtin_amdgcn_rcpf(d2.x), __builtin_amdgcn_rcpf(d2.y)}; o[n * 4 + e] = r2.x; o[n * 4 + e + 1] = r2.y; }
                    u32x4 w; w.x = cvt_pk_bf16(o[0], o[1]); w.y = cvt_pk_bf16(o[2], o[3]); w.z = cvt_pk_bf16(o[4], o[5]); w.w = cvt_pk_bf16(o[6], o[7]);
                    *(u32x4*)rowp = w;
                    asm volatile("" ::: "memory");
                }
        } else if (u.tag == T_ZEV || u.tag == T_ZODD || u.tag == T_FOUR || u.tag == T_FOURC || u.tag == T_FOUR2) {
            float sc = 1.f; bool rp = false; size_t rbase; int cbase = u.pn * BM; int ldo = ldc;
            if (u.tag == T_ZODD) { rbase = (size_t)u.pm * BM; if (u.pn >= 3 && u.pn < 6) sc = QSCALE; rp = (u.pn >= 3) && (u.pm < 64); }
            else if (u.tag == T_ZEV) rbase = (size_t)u.pm * BM;
            else if (u.tag == T_FOUR) { rbase = (size_t)u.pn * TL + (size_t)u.pm * BM; cbase = 0; sc = 0.00276213586400995f; }
            else if (u.tag == T_FOUR2) { rbase = (size_t)u.pn * TL + (size_t)u.pm * BM; cbase = 0; sc = 0.00276213586400995f; dst = (bf16_t*)(ws + WS_FP1); ldo = 256; }
            else { rbase = (size_t)NLAT + (size_t)u.pn * TC; cbase = 0; sc = 0.0078125f; }
#pragma unroll
            for (int ai = 0; ai < 2; ++ai)
#pragma unroll
                for (int m = 0; m < 4; ++m) {
                    if (ai == 1 && u.half != 0) continue;
                    const size_t row = rbase + ((u.half == 2) ? HALF : 0) + lr0 + ai * HALF + m * 16;
                    bf16_t* rowp = dst + row * ldo + cbase + lc0;
                    f32x4 cs[2], sn[2];
                    if (rp) {
                        const int t = (int)(row & (TL - 1)); const float* rt = rope + t * 64 + (wc & 1) * 16 + 8 * (fq & 1);
                        cs[0] = *(const f32x4*)(rt); cs[1] = *(const f32x4*)(rt + 4); sn[0] = *(const f32x4*)(rt + 32); sn[1] = *(const f32x4*)(rt + 36);
                    }
#pragma unroll
                    for (int bj = 0; bj < 2; ++bj) {
                        float o[8];
#pragma unroll
                        for (int n = 0; n < 2; ++n)
#pragma unroll
                            for (int e = 0; e < 4; ++e) {
                                float v = acc[ai][bj][m][n][e];
                                if (rp) { const float pv = __shfl_xor(v, 32); const float sg = (fq < 2) ? -sn[n][e] : sn[n][e]; v = v * cs[n][e] + pv * sg; }
                                o[n * 4 + e] = v * sc;
                            }
                        u32x4 w; w.x = cvt_pk_bf16(o[0], o[1]); w.y = cvt_pk_bf16(o[2], o[3]); w.z = cvt_pk_bf16(o[4], o[5]); w.w = cvt_pk_bf16(o[6], o[7]);
                        *(u32x4*)(rowp + bj * HALF) = w;
                    }
                    asm volatile("" ::: "memory");
                }
        } else {
            const bool lat = u.pn < 64; const int b = lat ? (u.pn >> 3) : (u.pn - 64);
            bf16_t* base; size_t pitch; int k0;
            if (u.tag == T_TRV) { base = vt + (size_t)b * 768 * KVT + (size_t)(u.pm * BM) * KVT; pitch = KVT; k0 = lat ? (u.pn & 7) * 256 : TL; }
            else if (lat) { base = pqt + (size_t)b * 256 * 4096; pitch = 4096; k0 = u.pm * TL + (u.pn & 7) * 256; }
            else { base = pqtc + (size_t)b * 256 * 512; pitch = 512; k0 = u.pm * TC; }
#pragma unroll
            for (int ai = 0; ai < 2; ++ai)
#pragma unroll
                for (int m = 0; m < 4; ++m) {
                    if (ai == 1 && u.half != 0) continue;
                    bf16_t* rowp = base + (size_t)(((u.half == 2) ? HALF : 0) + lr0 + ai * HALF + m * 16) * pitch + k0 + lc0;
#pragma unroll
                    for (int bj = 0; bj < 2; ++bj) {
                        const f32x4 v0 = acc[ai][bj][m][0], v1 = acc[ai][bj][m][1];
                        u32x4 w; w.x = cvt_pk_bf16(v0[0], v0[1]); w.y = cvt_pk_bf16(v0[2], v0[3]); w.z = cvt_pk_bf16(v1[0], v1[1]); w.w = cvt_pk_bf16(v1[2], v1[3]);
                        *(u32x4*)(rowp + bj * HALF) = w;
                    }
                }
        }
    }
};
struct EpiR {
    static constexpr bool PERM = false, AFTER_DRAIN = false;
    const float* in_lat; const float* in_ctx; float* out_lat; float* out_ctx; const float* gate; float coef;
    __device__ __forceinline__ void operator()(const f32x4 (&acc)[2][2][4][2], const Unit& u, int wr, int wc, int fr, int fq) const {
        const bool lat = u.pm < 64; const int cond = lat ? (u.pm >> 3) : 8;
        const float* ib = lat ? in_lat + (size_t)u.pm * BM * D : in_ctx + (size_t)(u.pm - 64) * BM * D;
        float* ob = lat ? out_lat + (size_t)u.pm * BM * D : out_ctx + (size_t)(u.pm - 64) * BM * D;
        const int col0 = u.pn * BM + wc * 32 + 4 * fq; const float* gp = gate + (size_t)cond * (NMOD * D) + col0;
        f32x4 gv[2][2];
#pragma unroll
        for (int bj = 0; bj < 2; ++bj)
#pragma unroll
            for (int n = 0; n < 2; ++n) gv[bj][n] = *(const f32x4*)(gp + bj * HALF + n * 16) * coef;
#pragma unroll
        for (int ai = 0; ai < 2; ++ai)
#pragma unroll
            for (int m = 0; m < 4; ++m) {
                const size_t off = (size_t)(ai * HALF + wr * 64 + m * 16 + fr) * D + col0;
#pragma unroll
                for (int bj = 0; bj < 2; ++bj)
#pragma unroll
                    for (int n = 0; n < 2; ++n) { const f32x4 hv = *(const f32x4*)(ib + off + bj * HALF + n * 16); *(f32x4*)(ob + off + bj * HALF + n * 16) = hv + gv[bj][n] * acc[ai][bj][m][n]; }
            }
    }
};

struct EpiP {
    static constexpr bool PERM = false, AFTER_DRAIN = false;
    bf16_t* P;
    __device__ __forceinline__ void operator()(const f32x4 (&acc)[2][2][4][2], const Unit& u, int wr, int wc, int fr, int fq) const {
        int fr_ = fr, fq_ = fq; asm volatile("" : "+v"(fr_), "+v"(fq_));
        bf16_t* base = P + ((size_t)u.tag * NCTX + (size_t)(u.pm - 64) * BM) * D + u.pn * BM + wc * 32 + 4 * fq_;
#pragma unroll
        for (int ai = 0; ai < 2; ++ai)
#pragma unroll
            for (int m = 0; m < 4; ++m) {
                bf16_t* rp = base + (size_t)(ai * HALF + wr * 64 + m * 16 + fr_) * D;
#pragma unroll
                for (int bj = 0; bj < 2; ++bj)
#pragma unroll
                    for (int n = 0; n < 2; ++n) { const f32x4 v = acc[ai][bj][m][n]; u32x2 w; w.x = cvt_pk_bf16(v[0], v[1]); w.y = cvt_pk_bf16(v[2], v[3]); *(u32x2*)(rp + bj * HALF + n * 16) = w; }
            }
    }
};

struct EpiRN {
    static constexpr bool PERM = false, AFTER_DRAIN = true;
    const float* in; const float* gate; float* outf; const float* gfin;
    float* hout; bf16_t* aout; const float* gain; const float* scsh;
    float* xbuf; unsigned* cnt; float coef; int mode;
    __device__ __forceinline__ void fused(f32x4 (&acc)[2][2][4][2], const Unit& u, int wr, int wc, int fr, int fq, LAS unsigned char* lds, int wid, int lane) const {
        LAS float* P = (LAS float*)lds;
        LAS float* S = (LAS float*)(lds + 4096);
        const int cond = u.pm >> 3;
        const int col0 = u.pn * BM + wc * 32 + 4 * fq;
        const float* ib = in + (size_t)u.pm * BM * D;
        const float* gp = gate + (size_t)cond * (NMOD * D) + col0;
        f32x4 gv[2][2];
#pragma unroll
        for (int bj = 0; bj < 2; ++bj)
#pragma unroll
            for (int n = 0; n < 2; ++n) gv[bj][n] = *(const f32x4*)(gp + bj * HALF + n * 16) * coef;
#pragma unroll
        for (int ai = 0; ai < 2; ++ai)
#pragma unroll
            for (int m = 0; m < 4; ++m) {
                const int lrow = ai * HALF + wr * 64 + m * 16 + fr; const size_t off = (size_t)lrow * D + col0; float ss = 0.f;
#pragma unroll
                for (int bj = 0; bj < 2; ++bj)
#pragma unroll
                    for (int n = 0; n < 2; ++n) { const f32x4 hn = *(const f32x4*)(ib + off + bj * HALF + n * 16) + gv[bj][n] * acc[ai][bj][m][n]; acc[ai][bj][m][n] = hn;
                        ss += (hn[0] * hn[0] + hn[1] * hn[1]) + (hn[2] * hn[2] + hn[3] * hn[3]); }
                ss += __shfl_xor(ss, 16); ss += __shfl_xor(ss, 32);
                if (fq == 0) P[lrow * 4 + wc] = ss;
                if (m & 1) asm volatile("" ::: "memory");
            }
        __syncthreads();
        const int row = wid * 32 + (lane & 31);
        float* slot = xbuf + ((size_t)(u.pm * BM + row) * 4);
        if (lane < 32) { const float t = (P[row * 4 + 0] + P[row * 4 + 1]) + (P[row * 4 + 2] + P[row * 4 + 3]);
            __hip_atomic_store(slot + u.pn, t, __ATOMIC_RELAXED, __HIP_MEMORY_SCOPE_AGENT); }
        asm volatile("s_waitcnt vmcnt(0)" ::: "memory");
        if (lane == 0) __hip_atomic_fetch_add(cnt + 64 * u.pm, 1u, __ATOMIC_RELAXED, __HIP_MEMORY_SCOPE_AGENT);
        if (wid == 0) {
            unsigned sp = 0;
            while ((unsigned)__builtin_amdgcn_readfirstlane(__hip_atomic_load(cnt + 64 * u.pm, __ATOMIC_RELAXED, __HIP_MEMORY_SCOPE_AGENT)) < 32u) { __builtin_amdgcn_s_sleep(2); if (++sp > (1u << 22)) break; }
            __builtin_amdgcn_fence(__ATOMIC_ACQUIRE, "agent");
        }
        asm volatile("s_waitcnt vmcnt(0) lgkmcnt(0)" ::: "memory");
        __syncthreads();
        if (lane < 32) { float q = 0.f;
#pragma unroll
            for (int t = 0; t < 4; ++t) q += __hip_atomic_load(slot + t, __ATOMIC_RELAXED, __HIP_MEMORY_SCOPE_AGENT);
            S[row] = rsqrtf(q * (1.f / D) + EPS); }
        __syncthreads();
        f32x4 g0[2][2], g1[2][2];
#pragma unroll
        for (int bj = 0; bj < 2; ++bj)
#pragma unroll
            for (int n = 0; n < 2; ++n) { const int c = col0 + bj * HALF + n * 16;
                if (mode == 0) { g0[bj][n] = *(const f32x4*)(gfin + c); g1[bj][n] = (f32x4){0.f, 0.f, 0.f, 0.f}; }
                else { const float* sp_ = scsh + (size_t)cond * (NMOD * D) + c; g0[bj][n] = *(const f32x4*)(gain + c) * (*(const f32x4*)(sp_ + D) + 1.0f); g1[bj][n] = *(const f32x4*)(sp_); } }
#pragma unroll
        for (int ai = 0; ai < 2; ++ai)
#pragma unroll
            for (int m = 0; m < 4; ++m) {
                const int lrow = ai * HALF + wr * 64 + m * 16 + fr; const size_t off = (size_t)(u.pm * BM + lrow) * D + col0; const float rs = S[lrow];
#pragma unroll
                for (int bj = 0; bj < 2; ++bj)
#pragma unroll
                    for (int n = 0; n < 2; ++n) { const f32x4 hn = acc[ai][bj][m][n]; const f32x4 y = (hn * rs) * g0[bj][n] + g1[bj][n];
                        if (mode == 0) *(f32x4*)(outf + off + bj * HALF + n * 16) = y;
                        else { *(f32x4*)(hout + off + bj * HALF + n * 16) = hn; u32x2 w; w.x = cvt_pk_bf16(y[0], y[1]); w.y = cvt_pk_bf16(y[2], y[3]); *(u32x2*)(aout + off + bj * HALF + n * 16) = w; } }
                if (m & 1) asm volatile("" ::: "memory");
            }
    }
};

template <class Epi, bool HM = false>
__device__ __forceinline__ void gemm_phase(LAS unsigned char* lds, const int tid, const int K, const int ld, const Sched& S, const Epi& E) {
    const int wid = __builtin_amdgcn_readfirstlane(tid >> 6), lane = tid & 63, wr = wid >> 2, wc = wid & 3, fr = lane & 15, fq = lane >> 4;
    const int nt = K / BK;
    unsigned voffA[2], voffB[2];
#pragma unroll
    for (int i = 0; i < 2; ++i) { int R, C; stage_rc(tid * 16 + i * 8192, R, C); const int Rb = Epi::PERM ? ((R & ~31) + perm32(R & 31)) : R;
        voffA[i] = (unsigned)(R * ld + C) * 2u; voffB[i] = (unsigned)(Rb * ld + C) * 2u; }
    const size_t kstep = (size_t)(BK * 2);
    const size_t hstep = (size_t)HALF * ld * 2;
    const unsigned ldsw = (unsigned)wid * 1024u;
    const int aoff = lds_byte(wr * 64 + fr, fq * 8), boff = lds_byte(wc * 32 + fr, fq * 8);
#define PG8_SA(b, h) (((b) * 2 + (h)) * HTB)
#define PG8_SB(b, h) ((4 + (b) * 2 + (h)) * HTB)
#define PG8_STAGE(bufoff, gbase, voff) do { _Pragma("unroll") for (int _i = 0; _i < 2; ++_i) \
        __builtin_amdgcn_global_load_lds((const unsigned*)((const char*)(gbase) + (voff)[_i]), (LAS unsigned*)(lds + (bufoff) + ldsw + _i * 8192), 16, 0, 0); } while (0)
#define PG8_LDA(dst, b, h) do { _Pragma("unroll") for (int m = 0; m < 4; ++m) _Pragma("unroll") for (int k = 0; k < 2; ++k) dst[m][k] = *(const LAS bf16x8*)(lds + PG8_SA(b, h) + aoff + m * 2048 + k * 1024); } while (0)
#define PG8_LDB(dst, b, h) do { _Pragma("unroll") for (int n = 0; n < 2; ++n) _Pragma("unroll") for (int k = 0; k < 2; ++k) dst[n][k] = *(const LAS bf16x8*)(lds + PG8_SB(b, h) + boff + n * 2048 + k * 1024); } while (0)
#define PG8_MMA(ai, bj, At, Bt) do { __builtin_amdgcn_s_setprio(1); _Pragma("unroll") for (int m = 0; m < 4; ++m) _Pragma("unroll") for (int n = 0; n < 2; ++n) _Pragma("unroll") for (int k = 0; k < 2; ++k) \
        acc[ai][bj][m][n] = __builtin_amdgcn_mfma_f32_16x16x32_bf16(Bt[n][k], At[m][k], acc[ai][bj][m][n], 0, 0, 0); __builtin_amdgcn_s_setprio(0); } while (0)
#define PG8_WAIT_V(n) asm volatile("s_waitcnt vmcnt(" #n ")" ::: "memory")
#define PG8_WAIT_L(n) asm volatile("s_waitcnt lgkmcnt(" #n ")" ::: "memory")
#define PG8_BAR __builtin_amdgcn_s_barrier()
#define PG8_SCHED __builtin_amdgcn_sched_barrier(0)
    Unit cur, nxt; int ui = 0;
    if (!S.next(0, cur)) return;
    f32x4 acc[2][2][4][2];
#pragma unroll
    for (int a = 0; a < 2; ++a)
#pragma unroll
        for (int b = 0; b < 2; ++b)
#pragma unroll
            for (int m = 0; m < 4; ++m)
#pragma unroll
                for (int n = 0; n < 2; ++n) acc[a][b][m][n] = (f32x4){0.f, 0.f, 0.f, 0.f};
    bf16x8 At[4][2], B0[2][2], B1[2][2];
    const char* cA = cur.a; const char* cB = cur.b;
    PG8_STAGE(PG8_SB(0, 0), cB, voffB); PG8_STAGE(PG8_SB(0, 1), cB + hstep, voffB); PG8_STAGE(PG8_SA(0, 0), cA, voffA); PG8_STAGE(PG8_SA(0, 1), cA + hstep, voffA);
    if (wr == 1) PG8_BAR;
    PG8_WAIT_V(2); PG8_BAR;
    PG8_STAGE(PG8_SB(1, 0), cB + kstep, voffB); PG8_STAGE(PG8_SA(1, 0), cA + kstep, voffA); PG8_STAGE(PG8_SB(1, 1), cB + hstep + kstep, voffB);
    PG8_WAIT_V(6); PG8_BAR;
    for (;;) {
        const bool hm = HM && (cur.half != 0);
        const bool has_next = S.next(ui + 1, nxt);
        const char* nA = has_next ? nxt.a : cA; const char* nB = has_next ? nxt.b : cB;
        for (int t = 0; t < nt; t += 2) {
            const bool last = (t == nt - 2);
            const char* a1 = cA + (size_t)(t + 1) * kstep;
            const char* a2 = last ? nA : cA + (size_t)(t + 2) * kstep; const char* b2 = last ? nB : cB + (size_t)(t + 2) * kstep;
            const char* a3 = a2 + kstep; const char* b3 = b2 + kstep;
            PG8_LDB(B0, 0, 0); PG8_LDB(B1, 0, 1); PG8_SCHED; PG8_LDA(At, 0, 0); PG8_STAGE(PG8_SA(1, 1), a1 + hstep, voffA);
            PG8_WAIT_V(8); PG8_WAIT_L(0); PG8_BAR; PG8_MMA(0, 0, At, B0); PG8_MMA(0, 1, At, B1); PG8_BAR; PG8_SCHED;
            if (!HM || !hm) PG8_LDA(At, 0, 1); PG8_STAGE(PG8_SB(0, 0), b2, voffB); PG8_STAGE(PG8_SB(0, 1), b2 + hstep, voffB); PG8_STAGE(PG8_SA(0, 0), a2, voffA);
            PG8_WAIT_V(8); PG8_WAIT_L(0); PG8_BAR; if (!HM || !hm) { PG8_MMA(1, 0, At, B0); PG8_MMA(1, 1, At, B1); } PG8_BAR; PG8_SCHED;
            PG8_LDB(B0, 1, 0); PG8_LDB(B1, 1, 1); PG8_SCHED; PG8_LDA(At, 1, 0); PG8_STAGE(PG8_SA(0, 1), a2 + hstep, voffA);
            PG8_WAIT_V(8); PG8_WAIT_L(0); PG8_BAR; PG8_MMA(0, 0, At, B0); PG8_MMA(0, 1, At, B1); PG8_BAR; PG8_SCHED;
            if (!HM || !hm) PG8_LDA(At, 1, 1); PG8_STAGE(PG8_SB(1, 0), b3, voffB); PG8_STAGE(PG8_SB(1, 1), b3 + hstep, voffB); PG8_STAGE(PG8_SA(1, 0), a3, voffA);
            PG8_WAIT_V(8); PG8_WAIT_L(0); PG8_BAR; if (!HM || !hm) { PG8_MMA(1, 0, At, B0); PG8_MMA(1, 1, At, B1); } PG8_BAR; PG8_SCHED;
        }
        if (wr == 0) PG8_BAR;
        if constexpr (!Epi::AFTER_DRAIN) E(acc, cur, wr, wc, fr, fq);
        if (!has_next) break;
#pragma unroll
        for (int a = 0; a < 2; ++a)
#pragma unroll
            for (int b = 0; b < 2; ++b)
#pragma unroll
                for (int m = 0; m < 4; ++m)
#pragma unroll
                    for (int n = 0; n < 2; ++n) acc[a][b][m][n] = (f32x4){0.f, 0.f, 0.f, 0.f};
        cur = nxt; cA = nA; cB = nB; ++ui;
        if (wr == 1) PG8_BAR;
    }
    PG8_WAIT_V(0);
    PG8_BAR;
    if constexpr (Epi::AFTER_DRAIN) E.fused(acc, cur, wr, wc, fr, fq, lds, wid, lane);
#undef PG8_SA
#undef PG8_SB
#undef PG8_STAGE
#undef PG8_LDA
#undef PG8_LDB
#undef PG8_MMA
#undef PG8_WAIT_V
#undef PG8_WAIT_L
#undef PG8_BAR
#undef PG8_SCHED
}
}

struct Frame {
    LAS unsigned char* lds; int tid, lane, wave, vcu, G;
    unsigned char* ws;
};
#define F_MOD ((float*)(F.ws + WS_MOD))
#define F_ROPE ((float*)(F.ws + WS_ROPE))
#define F_HC ((float*)(F.ws + WS_HC))
#define F_ABUF ((bf16_t*)(F.ws + WS_A))
#define F_ACT ((bf16_t*)(F.ws + WS_ACT))
#define F_VT ((bf16_t*)(F.ws + WS_VT))
#define F_PQT ((bf16_t*)(F.ws + WS_PQT))
#define F_PQTC ((bf16_t*)(F.ws + WS_PQTC))
#define F_OF ((bf16_t*)(F.ws + WS_OF))
#define F_OB ((bf16_t*)(F.ws + WS_OB))
#define F_CS ((bf16_t*)(F.ws + WS_CS))
#define F_CSC ((bf16_t*)(F.ws + WS_CSC))

__device__ __forceinline__ void mod_table(PRef p, Frame& F) {
    LAS float* sl = (LAS float*)F.lds;
    for (int i = F.tid; i < 9 * 1024; i += 512) { const int cond = i >> 10, k = i & 1023; const float v = cond < 8 ? p.c[cond * 1024 + k] : p.c_ctx[k]; sl[i] = silu_f(v); }
    __syncthreads();
}
__device__ __forceinline__ void mod_item(PRef p, Frame& F, int item) {
    LAS float* sl = (LAS float*)F.lds;
    LAS float* red = sl + 9 * 1024;
    const int l = item / 288, cb = item % 288, tid = F.tid;
    const int cq = tid & 7, kq = tid >> 3;
    const float* W = p.ada_w + (size_t)l * D * (NMOD * D) + 32 * cb + 4 * cq;
    f32x4 acc[9];
#pragma unroll
    for (int j = 0; j < 9; ++j) acc[j] = (f32x4){0.f, 0.f, 0.f, 0.f};
#pragma unroll 4
    for (int kk = 0; kk < 16; ++kk) {
        const int k = kq * 16 + kk; const f32x4 w = *(const f32x4*)(W + (size_t)k * (NMOD * D));
#pragma unroll
        for (int j = 0; j < 9; ++j) acc[j] += w * sl[j * 1024 + k];
    }
#pragma unroll
    for (int j = 0; j < 9; ++j)
#pragma unroll
        for (int e = 0; e < 4; ++e) red[(kq * 9 + j) * 32 + 4 * cq + e] = acc[j][e];
    __syncthreads();
    if (tid < 9 * 32) {
        const int j = tid >> 5, cc = tid & 31; float s = 0.f;
#pragma unroll 8
        for (int q = 0; q < 64; ++q) s += red[(q * 9 + j) * 32 + cc];
        F_MOD[(size_t)(l * 9 + j) * (NMOD * D) + 32 * cb + cc] = s + p.ada_b[l * (NMOD * D) + 32 * cb + cc];
    }
    __syncthreads();
}
__device__ __forceinline__ void tr_item(const float* W, int N, int K, int k0, int n0, bf16_t* drow, LAS float* scr, int lane) {
#pragma unroll 8
    for (int i = 0; i < 32; ++i) { const int kk = 2 * i + (lane >> 5); scr[kk * 33 + (lane & 31)] = W[(size_t)(k0 + kk) * N + n0 + (lane & 31)]; }
    asm volatile("s_waitcnt lgkmcnt(0)" ::: "memory");
    const int c = lane & 7;
#pragma unroll
    for (int j = 0; j < 4; ++j) { const int n = (lane >> 3) + 8 * j; const LAS float* s = scr + (8 * c) * 33 + n;
        u32x4 o; o.x = pk2(s[0 * 33], s[1 * 33]); o.y = pk2(s[2 * 33], s[3 * 33]); o.z = pk2(s[4 * 33], s[5 * 33]); o.w = pk2(s[6 * 33], s[7 * 33]);
        *(u32x4*)(drow + (size_t)n * K + k0 + 8 * c) = o; }
    asm volatile("s_waitcnt lgkmcnt(0)" ::: "memory");
}
__device__ __forceinline__ int ffn_in_row(int n0) { return n0 < FF ? (n0 / 128) * 256 + (n0 % 128) : ((n0 - FF) / 128) * 256 + 128 + ((n0 - FF) % 128); }

__device__ __forceinline__ void prep_items(PRef p, Frame& F, const int mode, const int gw, const int NGW) {
    LAS float* scr = (LAS float*)(F.lds + F.wave * 16384);
    const int lane = F.lane;
    constexpr int I_FI = 16 * 176, I_FO = 44 * 32, I_MO = 16 * 32, I_L = 2 * I_FI + 2 * I_FO + I_MO, I_EV = 16 * 73, I_OD = 16 * 96, I_FOLD = 256;
    constexpr int NITEMS = 2 * I_L + I_EV + I_OD + I_FOLD, NEARLY = I_FI + I_FO;
    constexpr int A2 = I_FO + I_MO, NA = I_FO + I_EV + I_FOLD, NB = I_FI + I_L + I_OD;
    const int nit = mode == 0 ? I_FI : mode == 1 ? NA : mode == 3 ? A2 : NB;
    for (int it = gw; it < nit; it += NGW) {
        int r;
        if (mode == 0) r = it;
        else if (mode == 1) r = it < I_FO ? 2 * I_FI + it : it < I_FO + I_EV ? 2 * I_L + (it - I_FO) : 2 * I_L + I_EV + I_OD + (it - I_FO - I_EV);
        else if (mode == 3) r = 2 * I_FI + I_FO + it;
        else r = it < I_FI ? I_FI + it : it < I_FI + I_L ? I_L + (it - I_FI) : 2 * I_L + I_EV + (it - I_FI - I_L);
        if (r < 2 * I_L) {
            const int l = r / I_L; r -= l * I_L; unsigned char* wl = F.ws + WS_W0 + (size_t)l * W_LAYER;
            if (r < 2 * I_FI) { const int which = r / I_FI; r -= which * I_FI; const int kb = r / 176, nb = r % 176;
                const float* W = (which ? p.ffn2_w_in : p.ffn1_w_in) + (size_t)l * D * 2 * FF; bf16_t* dst = (bf16_t*)(wl + (which ? W_F2I : W_F1I));
                tr_item(W, 2 * FF, D, kb * 64, nb * 32, dst + (size_t)ffn_in_row(nb * 32) * D, scr, lane); continue; }
            r -= 2 * I_FI;
            if (r < 2 * I_FO) { const int which = r / I_FO; r -= which * I_FO; const int kb = r / 32, nb = r % 32;
                const float* W = (which ? p.ffn2_w_out : p.ffn1_w_out) + (size_t)l * FF * D; bf16_t* dst = (bf16_t*)(wl + (which ? W_F2O : W_F1O));
                tr_item(W, D, FF, kb * 64, nb * 32, dst + (size_t)(nb * 32) * FF, scr, lane); continue; }
            r -= 2 * I_FO;
            { const int kb = r / 32, nb = r % 32; const float* W = p.mix_w_out + (size_t)l * D * D; bf16_t* dst = (bf16_t*)(wl + W_MO);
              tr_item(W, D, D, kb * 64, nb * 32, dst + (size_t)(nb * 32) * D, scr, lane); continue; }
        }
        r -= 2 * I_L;
        if (r < I_EV) { const int kb = r / 73, nb = 8 + r % 73, n0 = nb * 32; bf16_t* drow;
            bf16_t* wev = (bf16_t*)(F.ws + WS_WEV); bf16_t* wevv = (bf16_t*)(F.ws + WS_WEVV);
            if (n0 < 640) drow = wev + (size_t)(n0 - 256) * D;
            else if (n0 < 1024) drow = wev + (size_t)(384 + n0 - 640) * D;
            else if (n0 < 1792) drow = wevv + (size_t)(n0 - 1024) * D;
            else if (n0 < 2560) drow = wev + (size_t)(768 + n0 - 1792) * D;
            else drow = wev + (size_t)(1536 + n0 - 2560) * D;
            tr_item(p.even_w_in, 2592, D, kb * 64, n0, drow, scr, lane); continue; }
        r -= I_EV;
        if (r < I_OD) { const int kb = r / 96, nb = r % 96, n0 = nb * 32;
            bf16_t* drow = n0 < 2304 ? (bf16_t*)(F.ws + WS_WOD) + (size_t)n0 * D : (bf16_t*)(F.ws + WS_WODV) + (size_t)(n0 - 2304) * D;
            tr_item(p.odd_w_in, 3072, D, kb * 64, n0, drow, scr, lane); continue; }
        r -= I_OD;
        {
            const int kb = r & 15, g = (r >> 4) & 3, part = r >> 6;
            for (int i = lane; i < 64; i += 64) { scr[i] = __builtin_amdgcn_cosf((float)i * (1.f / 64.f)); scr[64 + i] = __builtin_amdgcn_sinf((float)i * (1.f / 64.f)); }
            asm volatile("s_waitcnt lgkmcnt(0)" ::: "memory");
            const int k = kb * 64 + lane; const float* wr = p.even_w_in + (size_t)k * 2592 + g * 64;
            float w[64];
#pragma unroll
            for (int c4 = 0; c4 < 16; ++c4) { const f32x4 v = *(const f32x4*)(wr + 4 * c4); w[4 * c4] = v[0]; w[4 * c4 + 1] = v[1]; w[4 * c4 + 2] = v[2]; w[4 * c4 + 3] = v[3]; }
            const bool isq = part >= 2; const int k2b = (part & 1) * 32; const LAS float* tw = scr + (isq ? 64 : 0);
            bf16_t* wpq = (bf16_t*)(F.ws + WS_WPQ);
            for (int kk = 0; kk < 32; ++kk) { const int k2 = k2b + kk; float s = 0.f;
#pragma unroll
                for (int c = 0; c < 64; ++c) s += w[c] * tw[(c * k2) & 63];
                if (isq) s = -s;
                wpq[(size_t)((isq ? 256 : 0) + g * 64 + k2) * D + k] = (bf16_t)f2bf(s); }
            asm volatile("s_waitcnt lgkmcnt(0)" ::: "memory");
        }
    }
}
__device__ __forceinline__ void prep_phase(PRef p, Frame& F) {
    mod_table(p, F);
    for (int it = F.vcu; it < 288; it += F.G) mod_item(p, F, it);
    prep_items(p, F, 0, F.vcu * 8 + F.wave, F.G * 8);
    const int gt = F.vcu * 512 + F.tid, NGT = F.G * 512;
    { u32x4* z = (u32x4*)((bf16_t*)(F.ws + WS_WEV) + (size_t)1568 * D); for (int i = gt; i < 224 * D / 8; i += NGT) z[i] = (u32x4){0u, 0u, 0u, 0u}; }
    for (int i = gt; i < 256 * 512; i += NGT) { const int k1 = i >> 9, cc = i & 511, t = cc & 255; const float fr = (float)((k1 * t) & 255) * (1.f / 256.f);
        F_CSC[i] = (bf16_t)f2bf(cc < 256 ? __builtin_amdgcn_cosf(fr) : __builtin_amdgcn_sinf(fr)); }
    for (int i = gt; i < TL * 32; i += NGT) { const int t = i >> 5, j = i & 31; const float pos = (float)(j < 16 ? (t >> 6) : (t & 63));
        const float inv = __builtin_amdgcn_exp2f(-(float)(j & 15) * (13.287712379549449f / 16.f)); const float ang = pos * inv;
        float rev = ang * 0.15915494309189535f; rev -= floorf(rev);
        F_ROPE[t * 64 + j] = __builtin_amdgcn_cosf(rev); F_ROPE[t * 64 + 32 + j] = __builtin_amdgcn_sinf(rev); }
}
__device__ __forceinline__ void cs_gen(Frame& F) {
    const int gt = F.vcu * 512 + F.tid, NGT = F.G * 512;
    for (int i = gt; i < TL * 512; i += NGT) { const int k1 = i >> 9, c8 = (i & 511) * 8; const bool sn = c8 >= TL; const int t0 = c8 & (TL - 1);
        float v[8];
#pragma unroll
        for (int e = 0; e < 8; ++e) { const float fr = (float)((k1 * (t0 + e)) & (TL - 1)) * (1.f / 2048.f); v[e] = sn ? __builtin_amdgcn_sinf(fr) : __builtin_amdgcn_cosf(fr); }
        u32x4 o; o.x = pk2(v[0], v[1]); o.y = pk2(v[2], v[3]); o.z = pk2(v[4], v[5]); o.w = pk2(v[6], v[7]);
        *(u32x4*)(F_CS + (size_t)k1 * 4096 + c8) = o; }
}
__device__ __forceinline__ void prenorm_phase(Frame& F, const float* src_lat, const float* src_ctx, int nrows, const float* gain, const float* modl, int slot_sh, const float* pgate = nullptr, float pcoef = 0.f, int r0 = 0, size_t a_off = WS_A, size_t part_off = WS_PART) {
    const int gw = F.vcu * 8 + F.wave, NGW = F.G * 8, lane = F.lane;
    for (int r = r0 + gw; r < nrows; r += NGW) {
        const bool lat = r < NLAT; const float* xr = lat ? src_lat + (size_t)r * D : src_ctx + (size_t)(r - NLAT) * D; const int cond = lat ? (r >> 11) : 8;
        const float* sh = modl + (size_t)cond * (NMOD * D) + slot_sh * D; const float* sc = sh + D;
        f32x4 v[4]; float s = 0.f;
#pragma unroll
        for (int j = 0; j < 4; ++j) { v[j] = *(const f32x4*)(xr + 4 * lane + 256 * j);
            if (pgate && !lat) {
                const bf16_t* pp = (const bf16_t*)(F.ws + part_off) + (size_t)(r - NLAT) * D + 4 * lane + 256 * j; f32x4 a = (f32x4){0.f, 0.f, 0.f, 0.f};
#pragma unroll
                for (int q = 0; q < 8; ++q) { const u32x2 w = *(const u32x2*)(pp + (size_t)q * NCTX * D); a += (f32x4){bf2f(w.x & 0xffffu), bf2f(w.x >> 16), bf2f(w.y & 0xffffu), bf2f(w.y >> 16)}; }
                v[j] += a * (*(const f32x4*)(pgate + 4 * lane + 256 * j) * pcoef);
                *(f32x4*)(F_HC + (size_t)(r - NLAT) * D + 4 * lane + 256 * j) = v[j]; }
            s += (v[j][0] * v[j][0] + v[j][1] * v[j][1]) + (v[j][2] * v[j][2] + v[j][3] * v[j][3]); }
        const float rstd = rsqrtf(wave_sum(s) * (1.f / D) + EPS);
        bf16_t* orow = (bf16_t*)(F.ws + a_off) + (size_t)r * D;
#pragma unroll
        for (int j = 0; j < 4; ++j) { const int c0 = 4 * lane + 256 * j; const f32x4 g = *(const f32x4*)(gain + c0), a = *(const f32x4*)(sc + c0), b = *(const f32x4*)(sh + c0);
            const f32x4 y = (v[j] * rstd) * g * (a + 1.0f) + b; u32x2 o; o.x = pk2(y[0], y[1]); o.y = pk2(y[2], y[3]); *(u32x2*)(orow + c0) = o; }
    }
}
__device__ __forceinline__ void final_norm_phase(PRef p, Frame& F) {
    const int gw = F.vcu * 8 + F.wave, NGW = F.G * 8, lane = F.lane;
    for (int r = gw; r < NLAT; r += NGW) {
        float* xr = p.out + (size_t)r * D; f32x4 v[4]; float s = 0.f;
#pragma unroll
        for (int j = 0; j < 4; ++j) { v[j] = *(const f32x4*)(xr + 4 * lane + 256 * j); s += (v[j][0] * v[j][0] + v[j][1] * v[j][1]) + (v[j][2] * v[j][2] + v[j][3] * v[j][3]); }
        const float rstd = rsqrtf(wave_sum(s) * (1.f / D) + EPS);
#pragma unroll
        for (int j = 0; j < 4; ++j) { const int c0 = 4 * lane + 256 * j; const f32x4 g = *(const f32x4*)(p.final_norm + c0); *(f32x4*)(xr + c0) = (v[j] * rstd) * g; }
    }
}

__device__ __forceinline__ void gla_stream(PRef p, Frame& F, int sid) {
    const int tid = F.tid, lane = F.lane, w = F.wave, fr = lane & 15, fq = lane >> 4;
    const int dir = sid & 1, bh = sid >> 1, b = bh / 6, h = bh % 6;
    constexpr int SET = 4 * 64 * 72 + 128 * 72 - 64 * 72;
    LAS bf16_t* stg = (LAS bf16_t*)F.lds;
    LAS bf16_t* att = stg + 2 * SET;
    LAS bf16_t* Sb = att + 64 * 72;
    LAS float* ebl = (LAS float*)(Sb + 128 * 72);
    LAS float* gwl = ebl + 128;
    LAS float* gbl = gwl + 16 * 64;
    const bf16_t* z = F_ACT; const bf16_t* VT = F_VT + (size_t)(b * 768 + h * 128) * KVT; bf16_t* obuf = dir ? F_OB : F_OF;
    for (int i = tid; i < 16 * 64; i += 512) gwl[i] = p.gla_gate_w[(size_t)(dir * 16 + (i >> 6)) * 384 + h * 64 + (i & 63)];
    if (tid < 64) gbl[tid] = p.gla_gate_b[dir * 384 + h * 64 + tid];
    f32x4 st[4];
#pragma unroll
    for (int nb = 0; nb < 4; ++nb) st[nb] = (f32x4){0.f, 0.f, 0.f, 0.f};
    for (int i = tid; i < 128 * 72 / 2; i += 512) ((LAS unsigned*)Sb)[i] = 0u;
    u32x4 qraw, kraw, g0, g1, vraw[2];
#define GLA_ROW0(step_) (((step_) < 4) ? (size_t)NLAT + b * TC + 64 * (dir ? 3 - (step_) : (step_)) : (size_t)b * TL + 64 * (dir ? 35 - (step_) : (step_) - 4))
#define GLA_KV0(step_) (((step_) < 4) ? TL + 64 * (dir ? 3 - (step_) : (step_)) : 64 * (dir ? 35 - (step_) : (step_) - 4))
#define GLA_LOAD(step_) do { const bf16_t* zr_ = z + (GLA_ROW0(step_) + tk) * EV_LD; \
        qraw = *(const u32x4*)(zr_ + h * 64 + 8 * w); kraw = *(const u32x4*)(zr_ + 384 + h * 64 + 8 * w); \
        g0 = *(const u32x4*)(zr_ + 1536 + dir * 16); g1 = *(const u32x4*)(zr_ + 1536 + dir * 16 + 8); \
        const int kv0_ = GLA_KV0(step_); _Pragma("unroll") for (int i_ = 0; i_ < 2; ++i_) { const int id_ = tid + 512 * i_; vraw[i_] = *(const u32x4*)(VT + (size_t)(id_ >> 3) * KVT + kv0_ + (id_ & 7) * 8); } } while (0)
    const int tk = dir ? 63 - lane : lane;
    GLA_LOAD(0);
    __syncthreads();
    for (int step = 0; step < 36; ++step) {
        const size_t row0 = GLA_ROW0(step);
        LAS bf16_t* qd = stg + (step & 1) * SET; LAS bf16_t* kd = qd + 64 * 72; LAS bf16_t* kdT = kd + 64 * 72; LAS bf16_t* Vt = kdT + 64 * 72; LAS float* eb = ebl + (step & 1) * 64;
        float zg[16], q8[8], k8[8];
#pragma unroll
        for (int qq = 0; qq < 4; ++qq) { zg[2 * qq] = bf2f(g0[qq] & 0xffffu); zg[2 * qq + 1] = bf2f(g0[qq] >> 16); zg[8 + 2 * qq] = bf2f(g1[qq] & 0xffffu); zg[8 + 2 * qq + 1] = bf2f(g1[qq] >> 16);
            q8[2 * qq] = bf2f(qraw[qq] & 0xffffu); q8[2 * qq + 1] = bf2f(qraw[qq] >> 16); k8[2 * qq] = bf2f(kraw[qq] & 0xffffu); k8[2 * qq + 1] = bf2f(kraw[qq] >> 16); }
#pragma unroll
        for (int i = 0; i < 2; ++i) { const int id = tid + 512 * i; *(LAS u32x4*)(Vt + (id >> 3) * 72 + (id & 7) * 8) = vraw[i]; }
        if (step + 1 < 36) GLA_LOAD(step + 1);
        float lg[8];
        { f32x4 x0 = *(const LAS f32x4*)(gbl + 8 * w), x1 = *(const LAS f32x4*)(gbl + 8 * w + 4);
#pragma unroll
          for (int r = 0; r < 16; ++r) { const f32x4 w0 = *(const LAS f32x4*)(gwl + r * 64 + 8 * w), w1 = *(const LAS f32x4*)(gwl + r * 64 + 8 * w + 4); x0 += w0 * zg[r]; x1 += w1 * zg[r]; }
#pragma unroll
          for (int j = 0; j < 4; ++j) { lg[j] = (fminf(x0[j], 0.f) - __logf(1.f + __expf(-fabsf(x0[j])))) * (1.f / 16.f); lg[4 + j] = (fminf(x1[j], 0.f) - __logf(1.f + __expf(-fabsf(x1[j])))) * (1.f / 16.f); } }
#pragma unroll
        for (int j = 0; j < 8; ++j) { float x = lg[j];
            x += DPPF(x, 0x111, 0xf, 0xf); x += DPPF(x, 0x112, 0xf, 0xf); x += DPPF(x, 0x114, 0xf, 0xf); x += DPPF(x, 0x118, 0xf, 0xf);
            x += DPPF(x, 0x142, 0xa, 0xf); x += DPPF(x, 0x143, 0xc, 0xf); lg[j] = x; }
        float qo[8], ko[8], kc[8];
#pragma unroll
        for (int j = 0; j < 8; j += 2) {
            const float bl0 = __int_as_float(__builtin_amdgcn_readlane(__float_as_int(lg[j]), 63)), bl1 = __int_as_float(__builtin_amdgcn_readlane(__float_as_int(lg[j + 1]), 63));
            const f32x2_t qq = (f32x2_t){q8[j], q8[j + 1]} * 0.125f, kk = (f32x2_t){k8[j], k8[j + 1]};
            const f32x2_t e1 = (f32x2_t){__expf(lg[j]), __expf(lg[j + 1])}, e2 = (f32x2_t){__expf(-lg[j]), __expf(-lg[j + 1])}, e3 = (f32x2_t){__expf(bl0 - lg[j]), __expf(bl1 - lg[j + 1])};
            const f32x2_t a_ = qq * e1, b_ = kk * e2, c_ = kk * e3;
            qo[j] = a_.x; qo[j + 1] = a_.y; ko[j] = b_.x; ko[j + 1] = b_.y; kc[j] = c_.x; kc[j + 1] = c_.y;
            if (lane == 0) { eb[8 * w + j] = __expf(bl0); eb[8 * w + j + 1] = __expf(bl1); } }
        { u32x4 o; o.x = pk2(qo[0], qo[1]); o.y = pk2(qo[2], qo[3]); o.z = pk2(qo[4], qo[5]); o.w = pk2(qo[6], qo[7]); *(LAS u32x4*)(qd + tk * 72 + 8 * w) = o;
          o.x = pk2(ko[0], ko[1]); o.y = pk2(ko[2], ko[3]); o.z = pk2(ko[4], ko[5]); o.w = pk2(ko[6], ko[7]); *(LAS u32x4*)(kd + tk * 72 + 8 * w) = o; }
#pragma unroll
        for (int j = 0; j < 8; ++j) kdT[(8 * w + j) * 72 + tk] = (bf16_t)f2bf(kc[j]);
        __syncthreads();
        {
            const int ib = w >> 1, jb0 = 2 * (w & 1);
            const bf16x8 a0 = *(const LAS bf16x8*)(qd + (16 * ib + fr) * 72 + fq * 8), a1 = *(const LAS bf16x8*)(qd + (16 * ib + fr) * 72 + 32 + fq * 8);
#pragma unroll
            for (int jj = 0; jj < 2; ++jj) { const int jb = jb0 + jj;
                const bf16x8 b0 = *(const LAS bf16x8*)(kd + (16 * jb + fr) * 72 + fq * 8), b1 = *(const LAS bf16x8*)(kd + (16 * jb + fr) * 72 + 32 + fq * 8);
                f32x4 cc = (f32x4){0.f, 0.f, 0.f, 0.f}; cc = MFMA16(a0, b0, cc); cc = MFMA16(a1, b1, cc);
#pragma unroll
                for (int e = 0; e < 4; ++e) { const int i = 16 * ib + 4 * fq + e, j = 16 * jb + fr; const bool keep = dir ? (j >= i) : (j <= i); att[i * 72 + j] = (bf16_t)f2bf(keep ? cc[e] : 0.f); } }
        }
        __syncthreads();
        {
            const bf16x8 sA0 = *(const LAS bf16x8*)(Sb + (16 * w + fr) * 72 + fq * 8), sA1 = *(const LAS bf16x8*)(Sb + (16 * w + fr) * 72 + 32 + fq * 8);
            const bf16x8 vA0 = *(const LAS bf16x8*)(Vt + (16 * w + fr) * 72 + fq * 8), vA1 = *(const LAS bf16x8*)(Vt + (16 * w + fr) * 72 + 32 + fq * 8);
#pragma unroll
            for (int ib = 0; ib < 4; ++ib) {
                const bf16x8 q0 = *(const LAS bf16x8*)(qd + (16 * ib + fr) * 72 + fq * 8), q1 = *(const LAS bf16x8*)(qd + (16 * ib + fr) * 72 + 32 + fq * 8);
                const bf16x8 t0 = *(const LAS bf16x8*)(att + (16 * ib + fr) * 72 + fq * 8), t1 = *(const LAS bf16x8*)(att + (16 * ib + fr) * 72 + 32 + fq * 8);
                f32x4 cc = (f32x4){0.f, 0.f, 0.f, 0.f}; cc = MFMA16(sA0, q0, cc); cc = MFMA16(sA1, q1, cc); cc = MFMA16(vA0, t0, cc); cc = MFMA16(vA1, t1, cc);
                u32x2 o; o.x = pk2(cc[0], cc[1]); o.y = pk2(cc[2], cc[3]);
                *(u32x2*)(obuf + (row0 + 16 * ib + fr) * 768 + h * 128 + 16 * w + 4 * fq) = o;
            }
#pragma unroll
            for (int nb = 0; nb < 4; ++nb) {
                const float dcy = eb[16 * nb + fr]; st[nb] = st[nb] * dcy;
                const bf16x8 k0 = *(const LAS bf16x8*)(kdT + (16 * nb + fr) * 72 + fq * 8), k1 = *(const LAS bf16x8*)(kdT + (16 * nb + fr) * 72 + 32 + fq * 8);
                st[nb] = MFMA16(vA0, k0, st[nb]); st[nb] = MFMA16(vA1, k1, st[nb]);
#pragma unroll
                for (int e = 0; e < 4; ++e) Sb[(16 * w + 4 * fq + e) * 72 + 16 * nb + fr] = (bf16_t)f2bf(st[nb][e]);
            }
        }
    }
#undef GLA_LOAD
#undef GLA_ROW0
#undef GLA_KV0
    __syncthreads();
}
__device__ __forceinline__ void combine_phase(PRef p, Frame& F) {
    const int gw = F.vcu * 8 + F.wave, NGW = F.G * 8, lane = F.lane;
    for (int r = gw; r < NROW; r += NGW) {
        if (r < NLAT) {
            bf16_t* mp = F_ABUF + (size_t)r * D + lane * 4; const u32x2 a = *(const u32x2*)mp, bq = *(const u32x2*)((const bf16_t*)(F.ws + WS_FP1) + (size_t)r * 256 + lane * 4);
            u32x2 o; o.x = pk2(bf2f(a.x & 0xffffu) + bf2f(bq.x & 0xffffu), bf2f(a.x >> 16) + bf2f(bq.x >> 16)); o.y = pk2(bf2f(a.y & 0xffffu) + bf2f(bq.y & 0xffffu), bf2f(a.y >> 16) + bf2f(bq.y >> 16));
            *(u32x2*)mp = o;
        }
#pragma unroll
        for (int it = 0; it < 3; ++it) {
            const int idx = it * 256 + lane * 4;
            const u32x2 a = *(const u32x2*)(F_OF + (size_t)r * 768 + idx), bq = *(const u32x2*)(F_OB + (size_t)r * 768 + idx), zr = *(const u32x2*)(F_ACT + (size_t)r * EV_LD + 768 + idx);
            float v[4] = {bf2f(a.x & 0xffffu) + bf2f(bq.x & 0xffffu), bf2f(a.x >> 16) + bf2f(bq.x >> 16), bf2f(a.y & 0xffffu) + bf2f(bq.y & 0xffffu), bf2f(a.y >> 16) + bf2f(bq.y >> 16)};
            float ss = (v[0] * v[0] + v[1] * v[1]) + (v[2] * v[2] + v[3] * v[3]);
#pragma unroll
            for (int o = 1; o < 32; o <<= 1) ss += __shfl_xor(ss, o);
            const float rstd = rsqrtf(ss * (1.f / 128.f) + EPS);
            const f32x4 g = *(const f32x4*)(p.gla_norm + (idx & 127));
            const float z0 = bf2f(zr.x & 0xffffu), z1 = bf2f(zr.x >> 16), z2 = bf2f(zr.y & 0xffffu), z3 = bf2f(zr.y >> 16);
            u32x2 o; o.x = pk2(v[0] * rstd * g[0] * silu_f(z0), v[1] * rstd * g[1] * silu_f(z1)); o.y = pk2(v[2] * rstd * g[2] * silu_f(z2), v[3] * rstd * g[3] * silu_f(z3));
            *(u32x2*)(F_ABUF + (size_t)r * D + 256 + idx) = o;
        }
    }
}

__device__ __forceinline__ void conv_part(PRef p, Frame& F) {
    const int gt = F.vcu * 512 + F.tid, NGT = F.G * 512; const bf16_t* z = F_ACT;
    for (int i = gt; i < NLAT * 32; i += NGT) {
        const int row = i >> 5, c8 = (i & 31) * 8, t = row & (TL - 1);
        const bf16_t* zr = z + (size_t)row * OD_LD;
        const u32x4 zb = *(const u32x4*)(zr + c8), c1 = *(const u32x4*)(zr + 256 + c8), x1 = *(const u32x4*)(zr + 512 + c8);
        u32x4 c0 = (u32x4){0u, 0u, 0u, 0u}, x0 = c0, c2 = c0, x2 = c0;
        if (t > 0) { c0 = *(const u32x4*)(zr - OD_LD + 256 + c8); x0 = *(const u32x4*)(zr - OD_LD + 512 + c8); }
        if (t < TL - 1) { c2 = *(const u32x4*)(zr + OD_LD + 256 + c8); x2 = *(const u32x4*)(zr + OD_LD + 512 + c8); }
        float o[8];
#pragma unroll
        for (int q = 0; q < 4; ++q)
#pragma unroll
            for (int hh = 0; hh < 2; ++hh) {
                const int c = c8 + 2 * q + hh;
                const float u0 = (hh ? bf2f(c0[q] >> 16) : bf2f(c0[q] & 0xffffu)) * (hh ? bf2f(x0[q] >> 16) : bf2f(x0[q] & 0xffffu));
                const float u1 = (hh ? bf2f(c1[q] >> 16) : bf2f(c1[q] & 0xffffu)) * (hh ? bf2f(x1[q] >> 16) : bf2f(x1[q] & 0xffffu));
                const float u2 = (hh ? bf2f(c2[q] >> 16) : bf2f(c2[q] & 0xffffu)) * (hh ? bf2f(x2[q] >> 16) : bf2f(x2[q] & 0xffffu));
                const float zbv = hh ? bf2f(zb[q] >> 16) : bf2f(zb[q] & 0xffffu);
                o[2 * q + hh] = zbv * (u0 * p.conv_w[c] + u1 * p.conv_w[256 + c] + u2 * p.conv_w[512 + c] + p.conv_b[c]);
            }
        u32x4 w; w.x = pk2(o[0], o[1]); w.y = pk2(o[2], o[3]); w.z = pk2(o[4], o[5]); w.w = pk2(o[6], o[7]);
        *(u32x4*)(F_ABUF + (size_t)row * D + c8) = w;
    }
}
__device__ __forceinline__ void attn_unit(PRef p, Frame& F, int unit, float lam) {
    const int tid = F.tid, lane = F.lane, w = F.wave, r32 = lane & 31, hi = lane >> 5, s = w >> 2, qw = w & 3;
    const int bh = unit >> 4, qh = unit & 15, b = bh / 6, h = bh % 6, q0 = qh * 128;
    constexpr int KROW = 272, VROW = 136, KBUF = 64 * KROW, VBUF = 128 * VROW, VOFF = 2 * KBUF;
    const bf16_t* z = F_ACT; const bf16_t* VT = F_VT + (size_t)(b * 768 + h * 128) * KVT;
    const size_t qrow = (size_t)b * TL + q0 + 32 * qw + r32;
    bf16x8 qr[4];
#pragma unroll
    for (int d0 = 0; d0 < 4; ++d0) qr[d0] = *(const bf16x8*)(z + qrow * OD_LD + 768 + h * 128 + s * 64 + d0 * 16 + hi * 8);
    int kr[2], kc[2], vr[2], vc[2];
#pragma unroll
    for (int i = 0; i < 2; ++i) { const int id = tid + 512 * i; kr[i] = id >> 4; kc[i] = id & 15; vr[i] = id >> 3; vc[i] = id & 7; }
    u32x4 kreg[2], vreg[2];
    const char* kbase_lat = (const char*)(z + ((size_t)b * TL) * OD_LD + 1536 + h * 128); const char* kbase_ctx = (const char*)(z + ((size_t)NLAT + (size_t)b * TC) * OD_LD + 1536 + h * 128);
    unsigned koffb[2], voffb[2];
#pragma unroll
    for (int i = 0; i < 2; ++i) { koffb[i] = (unsigned)(kr[i] * OD_LD + kc[i] * 8) * 2u; voffb[i] = (unsigned)(vr[i] * KVT + vc[i] * 8) * 2u; }
#define ATT_LOADK(t) do { const char* kb_ = (t) < 32 ? kbase_lat + (size_t)(t) * (64 * OD_LD * 2) : kbase_ctx + (size_t)((t) - 32) * (64 * OD_LD * 2); \
        _Pragma("unroll") for (int i = 0; i < 2; ++i) kreg[i] = *(const u32x4*)(kb_ + koffb[i]); } while (0)
#define ATT_LOADV(t) do { const char* vb_ = (const char*)VT + (size_t)(t) * 128; _Pragma("unroll") for (int i = 0; i < 2; ++i) vreg[i] = *(const u32x4*)(vb_ + voffb[i]); } while (0)
#define ATT_STOREK(buf) do { _Pragma("unroll") for (int i = 0; i < 2; ++i) *(LAS u32x4*)(F.lds + (buf) * KBUF + kr[i] * KROW + kc[i] * 16) = kreg[i]; } while (0)
#define ATT_STOREV(buf) do { _Pragma("unroll") for (int i = 0; i < 2; ++i) { \
        *(LAS u32x2*)(F.lds + VOFF + (buf) * VBUF + vr[i] * VROW + vc[i] * 16) = (u32x2){vreg[i].x, vreg[i].y}; \
        *(LAS u32x2*)(F.lds + VOFF + (buf) * VBUF + vr[i] * VROW + vc[i] * 16 + 8) = (u32x2){vreg[i].z, vreg[i].w}; } } while (0)
#define SB() do {} while (0)
#define Z16 ((f32x16){0.f, 0.f, 0.f, 0.f, 0.f, 0.f, 0.f, 0.f, 0.f, 0.f, 0.f, 0.f, 0.f, 0.f, 0.f, 0.f})
#define ATT_QK(kb_) do { const LAS unsigned char* Kb = F.lds + (kb_) * KBUF + r32 * KROW + (s * 64 + hi * 8) * 2; \
        _Pragma("unroll") for (int d0 = 0; d0 < 4; ++d0) { \
            const bf16x8 a0 = *(const LAS bf16x8*)(Kb + d0 * 32), a1 = *(const LAS bf16x8*)(Kb + 32 * KROW + d0 * 32); \
            if (d0 == 0) { p0 = MFMA32(a0, qr[0], Z16); p1 = MFMA32(a1, qr[0], Z16); } else { p0 = MFMA32(a0, qr[d0], p0); p1 = MFMA32(a1, qr[d0], p1); } } } while (0)
#define ATT_PVG(kb, ks) do { _Pragma("unroll") for (int nb = 0; nb < 4; ++nb) { \
            const LAS unsigned char* vp = Vb + nb * 32 * VROW + ((kb) * 32 + (ks) * 16) * 2; \
            const s16x4 lo = *(const LAS s16x4*)(vp), hh = *(const LAS s16x4*)(vp + 16); \
            const bf16x8 af = (bf16x8){lo[0], lo[1], lo[2], lo[3], hh[0], hh[1], hh[2], hh[3]}; \
            o[nb] = MFMA32(af, __builtin_bit_cast(bf16x8, pf[kb][ks]), o[nb]); } } while (0)
#define ATT_MAX8(P, B) fmaxf(fmaxf(fmaxf(fmaxf(fmaxf(fmaxf(fmaxf(P[B], P[B + 1]), P[B + 2]), P[B + 3]), P[B + 4]), P[B + 5]), P[B + 6]), P[B + 7])
#define ATT_EXP8(P, B, DST) do { _Pragma("unroll") for (int r = 0; r < 8; r += 2) {   \
            const f32x2_t d_ = (f32x2_t){P[B + r], P[B + r + 1]} - (f32x2_t){m_run, m_run}; \
            const f32x2_t e_ = (f32x2_t){__builtin_amdgcn_exp2f(d_.x), __builtin_amdgcn_exp2f(d_.y)}; rs2 += e_; P[B + r] = e_.x; P[B + r + 1] = e_.y; } \
        DST = (u32x4){cvt_pk_bf16(P[B], P[B + 1]), cvt_pk_bf16(P[B + 2], P[B + 3]), cvt_pk_bf16(P[B + 4], P[B + 5]), cvt_pk_bf16(P[B + 6], P[B + 7])}; } while (0)
    f32x16 o[4];
#pragma unroll
    for (int nb = 0; nb < 4; ++nb)
#pragma unroll
        for (int r = 0; r < 16; ++r) o[nb][r] = 0.f;
    float m_run = 0.f, l_run = 0.f;
    u32x4 pf[2][2]; f32x16 p0, p1;
    constexpr int NT = KVT / 64;
    ATT_LOADK(0); ATT_LOADV(0); ATT_STOREK(0); ATT_STOREV(0); ATT_LOADK(1); ATT_STOREK(1);
    __syncthreads();
    {
        ATT_QK(0);
        float mx = fmaxf(ATT_MAX8(p0, 0), ATT_MAX8(p0, 8)); mx = fmaxf(mx, fmaxf(ATT_MAX8(p1, 0), ATT_MAX8(p1, 8)));
        mx = fmaxf(mx, __shfl_xor(mx, 32)); m_run = mx;
        f32x2_t rs2 = (f32x2_t){0.f, 0.f};
        ATT_EXP8(p0, 0, pf[0][0]); ATT_EXP8(p0, 8, pf[0][1]); ATT_EXP8(p1, 0, pf[1][0]); ATT_EXP8(p1, 8, pf[1][1]);
        l_run = rs2.x + rs2.y;
    }
    __syncthreads();
    for (int t = 0; t < NT; ++t) {
        const bool more = t + 1 < NT;
        if (t + 2 < NT) ATT_LOADK(t + 2);
        if (more) ATT_LOADV(t + 1);
        const LAS unsigned char* Vb = F.lds + VOFF + (t & 1) * VBUF + r32 * VROW + hi * 8;
        if (more) {
            ATT_QK((t + 1) & 1);
            SB();
            ATT_PVG(0, 0);
            float mx = fmaxf(ATT_MAX8(p0, 0), ATT_MAX8(p0, 8));
            SB();
            ATT_PVG(0, 1);
            mx = fmaxf(mx, fmaxf(ATT_MAX8(p1, 0), ATT_MAX8(p1, 8)));
            mx = fmaxf(mx, __shfl_xor(mx, 32)) - m_run;
            const bool need = __any(mx > 8.0f);
            const float dl = need ? fmaxf(mx, 0.f) : 0.f; m_run += dl;
            const float alpha = __builtin_amdgcn_exp2f(-dl); l_run *= alpha;
            f32x2_t rs2 = (f32x2_t){0.f, 0.f};
            SB();
            ATT_PVG(1, 0);
            u32x4 n00, n01, n10, n11;
            ATT_EXP8(p0, 0, n00); ATT_EXP8(p0, 8, n01);
            SB();
            ATT_PVG(1, 1);
            ATT_EXP8(p1, 0, n10);
            SB();
            ATT_EXP8(p1, 8, n11);
            l_run += rs2.x + rs2.y;
            pf[0][0] = n00; pf[0][1] = n01; pf[1][0] = n10; pf[1][1] = n11;
            if (need) {
#pragma unroll
                for (int nb = 0; nb < 4; ++nb)
#pragma unroll
                    for (int r = 0; r < 16; ++r) o[nb][r] *= alpha;
            }
        } else {
            ATT_PVG(0, 0); ATT_PVG(0, 1); ATT_PVG(1, 0); ATT_PVG(1, 1);
        }
        if (t + 2 < NT) ATT_STOREK(t & 1);
        if (more) ATT_STOREV((t + 1) & 1);
        __syncthreads();
    }
#undef ATT_LOADK
#undef ATT_LOADV
#undef ATT_STOREK
#undef ATT_STOREV
#undef ATT_QK
#undef ATT_PVG
#undef ATT_MAX8
#undef ATT_EXP8
#undef SB
#undef Z16
    l_run += __shfl_xor(l_run, 32);
    const float inv = 1.0f / l_run;
    LAS float* ex = (LAS float*)F.lds;
    if (s == 1) {
#pragma unroll
        for (int nb = 0; nb < 4; ++nb)
#pragma unroll
            for (int r = 0; r < 16; ++r) ex[(qw * 64 + nb * 16 + r) * 64 + lane] = o[nb][r] * inv;
    }
    __syncthreads();
    if (s == 0) {
        float ss = 0.f;
#pragma unroll
        for (int nb = 0; nb < 4; ++nb)
#pragma unroll
            for (int r = 0; r < 16; ++r) { const float y = o[nb][r] * inv - lam * ex[(qw * 64 + nb * 16 + r) * 64 + lane]; o[nb][r] = y; ss += y * y; }
        ss += __shfl_xor(ss, 32);
        const float rstd = rsqrtf(ss * (1.f / 128.f) + EPS) * (1.0f - LAM_INIT);
        bf16_t* orow = F_ABUF + qrow * D + 256 + h * 128;
#pragma unroll
        for (int nb = 0; nb < 4; ++nb)
#pragma unroll
            for (int rq = 0; rq < 4; ++rq) {
                const int dv = 32 * nb + 8 * rq + 4 * hi; const f32x4 g = *(const f32x4*)(p.diff_norm + dv);
                u32x2 ov; ov.x = pk2(o[nb][4 * rq] * rstd * g[0], o[nb][4 * rq + 1] * rstd * g[1]); ov.y = pk2(o[nb][4 * rq + 2] * rstd * g[2], o[nb][4 * rq + 3] * rstd * g[3]);
                *(u32x2*)(orow + dv) = ov;
            }
    }
    __syncthreads();
}

#define XB_TMO      128
#define XB_XCNT(j)  (256  + 64 * (j))
#define XB_XSUB(j)  (1280 + 64 * (j))
#define XB_XGEN(j)  (2304 + 64 * (j))
#define XB_TOP      3328
#define XB_TOPGEN   3392
#define XCD_BAR_WORDS 3456
#define XB_SPIN_CAP (1u << 18)

__device__ __forceinline__ unsigned xb_ld(unsigned* p)              { return __hip_atomic_load(p, __ATOMIC_RELAXED, __HIP_MEMORY_SCOPE_AGENT); }
__device__ __forceinline__ unsigned xb_add(unsigned* p, unsigned v) { return __hip_atomic_fetch_add(p, v, __ATOMIC_RELAXED, __HIP_MEMORY_SCOPE_AGENT); }
__device__ __forceinline__ unsigned xb_xcc_id() { return (unsigned)__builtin_amdgcn_s_getreg((3 << 11) | 20) & 0xFu; }
#define XB_SPIN(cond, bar) do { unsigned _sp = 0; while (cond) { __builtin_amdgcn_s_sleep(1); \
    if ((++_sp & 255u) == 0u) { if (xb_ld(&(bar)[XB_TMO])) break; if (_sp > XB_SPIN_CAP) { atomicAdd(&(bar)[XB_TMO], 1u); break; } } } } while (0)

struct XcdBarrier {
    unsigned* bar; unsigned x;
    volatile LAS unsigned* st;
};

__device__ __forceinline__ XcdBarrier xcd_barrier_post(unsigned* bar, volatile LAS unsigned* st, const bool t0) {
    XcdBarrier b; b.bar = bar; b.x = xb_xcc_id(); b.st = st;
    if (t0) (void)xb_add(&bar[XB_XCNT(b.x)], 1u);
    return b;
}
__device__ __forceinline__ void xcd_barrier_complete(unsigned* bar, unsigned x, unsigned& nloc, unsigned& nx) {
    const unsigned G = gridDim.x * gridDim.y * gridDim.z;
    unsigned sum, cnt, mine, sp = 0u;
    for (;;) {
        sum = 0u; cnt = 0u; mine = 0u;
#pragma unroll
        for (unsigned j = 0; j < 16; ++j) { const unsigned c = xb_ld(&bar[XB_XCNT(j)]); sum += c; cnt += (c > 0u) ? 1u : 0u; mine = (j == x) ? c : mine; }
        if (sum == G) break;
        __builtin_amdgcn_s_sleep(1);
        if ((++sp & 255u) == 0u) { if (xb_ld(&bar[XB_TMO])) break; if (sp > XB_SPIN_CAP) { atomicAdd(&bar[XB_TMO], 1u); break; } }
    }
    nloc = mine > 0u ? mine : 1u; nx = cnt > 0u ? cnt : 1u;
}

__device__ __forceinline__ void xcd_barrier(const XcdBarrier& b, const bool t0) {
    asm volatile("s_waitcnt vmcnt(0)" ::: "memory");
    __syncthreads();
    if (t0) {
        unsigned* bar = b.bar;
        __builtin_amdgcn_s_waitcnt(0);
        unsigned nloc = b.st[0], nx = b.st[1];
        if (nloc == 0u) { xcd_barrier_complete(bar, b.x, nloc, nx); b.st[0] = nloc; b.st[1] = nx; }
        const unsigned old = xb_add(&bar[XB_XSUB(b.x)], 1u);
        const unsigned gen = old / nloc;
        if (old + 1u == (gen + 1u) * nloc) {
            __builtin_amdgcn_fence(__ATOMIC_RELEASE, "agent");
            asm volatile("s_waitcnt vmcnt(0)" ::: "memory");
            const unsigned og = xb_add(&bar[XB_TOP], 1u);
            const unsigned tg = og / nx;
            if (og + 1u == (tg + 1u) * nx) xb_add(&bar[XB_TOPGEN], 1u);
            else XB_SPIN(xb_ld(&bar[XB_TOPGEN]) == tg, bar);
            __builtin_amdgcn_fence(__ATOMIC_ACQUIRE, "agent");
            xb_add(&bar[XB_XGEN(b.x)], 1u);
            asm volatile("s_waitcnt vmcnt(0)" ::: "memory");
        } else {
            XB_SPIN(xb_ld(&bar[XB_XGEN(b.x)]) == gen, bar);
            __builtin_amdgcn_fence(__ATOMIC_ACQUIRE, "agent");
            asm volatile("s_waitcnt vmcnt(0)" ::: "memory");
        }
    }
    __syncthreads();
}


template <int ph>
__device__ __forceinline__ void run_phase(PRef p, Frame& F) {
        if (ph == 0) { prep_phase(p, F); }
        else if (ph == 23) { final_norm_phase(p, F); }
        else {
            const int l = (ph - 1) / 11, q = (ph - 1) % 11;
            const unsigned wl = (unsigned)(WS_W0 + (size_t)l * W_LAYER);
            const float* modl = F_MOD + (size_t)l * 9 * (NMOD * D);
            const bool l0 = (l == 0);
            if (q == 0 || q == 3 || q == 8) {
                const float* sl = (l0 && q == 0) ? p.x : p.out; const float* sc = (l0 && q == 0) ? p.ctx : F_HC;
                const float* gain = (q == 0 ? p.norm_ffn1 : q == 3 ? p.norm_mix : p.norm_ffn2) + l * D;
                const int nrows = (!l0 && q == 8) ? NLAT : NROW;
                if (l0 && q == 3) cs_gen(F);
                const bool hasp = !(l0 && q == 0) && !(!l0 && q == 8);
                const float* pg = hasp ? (q == 0 ? F_MOD + 8 * D : modl + (q == 3 ? 2 : 5) * D) + (size_t)8 * (NMOD * D) : nullptr;
                const float* scx = (l0 && q == 3) ? p.ctx : sc;
                const int r0 = ((q == 3) || (q == 8) || (!l0 && q == 0)) ? NLAT : 0;
                prenorm_phase(F, sl, scx, nrows, gain, modl, q == 0 ? 0 : q == 3 ? 3 : 6, pg, (q == 8) ? 1.0f : 0.5f, r0, (q == 8) ? WS_A2 : WS_A, (q == 8) ? WS_ACT : WS_PART);
            } else if (q == 1 || q == 9 || q == 4 || (q == 5 && l0)) {
                pg8::Sched S; S.nfull = 0; S.parts = 1; S.kpart = 0; S.kbase = 0; S.pbase = 0; S.G = F.G; S.vcu = F.vcu; S.coff = 0; S.tstep = 256u * D * 2u; S.ws = (const char*)F.ws;
                const pg8::Seg none{0u, 0u, 0u}; S.s0 = none; S.s1 = none; S.s2 = none;
                pg8::EpiT E; E.ws = F.ws; E.dst_off = (unsigned)WS_ACT; E.ldc = FF;
                int K = D, ld = D, njob = 1;
                if (q == 1 || q == 9) {
                    const int nM = (!l0 && q == 9) ? 64 : 72;
                    S.s0 = pg8::mkseg((unsigned)((q == 9) ? WS_A2 : WS_A), wl + (unsigned)(q == 1 ? W_F1I : W_F2I), nM, 22, 0, 0, pg8::T_SWIGLU);
                    S.nfull = ((nM * 22) / 256) * 256;
                } else if (q == 4 && l0) {
                    E.ldc = EV_LD;
                    S.s0 = pg8::mkseg((unsigned)WS_A, (unsigned)WS_WEV, 72, 7, 0, 0, pg8::T_ZEV);
                    S.s1 = pg8::mkseg((unsigned)WS_WEVV, (unsigned)WS_A, 3, 72, 0, 0, pg8::T_TRV);
                    S.s2 = pg8::mkseg((unsigned)WS_WPQ, (unsigned)WS_A, 2, 72, 0, 0, pg8::T_TRPQ);
                    S.nfull = 768;
                } else if (q == 4) {
                    E.ldc = OD_LD;
                    S.s0 = pg8::mkseg((unsigned)WS_A, (unsigned)WS_WOD, 64, 9, 0, 0, pg8::T_ZODD);
                    S.s1 = pg8::mkseg((unsigned)WS_A, (unsigned)WS_WOD, 8, 3, 64, 6, pg8::T_ZODD);
                    S.s2 = pg8::mkseg((unsigned)WS_WODV, (unsigned)WS_A, 3, 72, 0, 0, pg8::T_TRV);
                    S.nfull = 768;
                } else {
                    E.dst_off = (unsigned)WS_A; E.ldc = D; njob = 2; K = 2048; ld = 4096; S.tstep = 256u * 4096u * 2u;
                    S.s0 = pg8::mkseg((unsigned)WS_CS, (unsigned)WS_PQT, 8, 8, 0, 0, pg8::T_FOUR);
                    S.s1 = pg8::mkseg((unsigned)WS_CS + 4096u, (unsigned)WS_PQT + 4096u, 8, 8, 0, 0, pg8::T_FOUR2);
                }
#pragma unroll 1
                for (int j = 0; j < njob; ++j) {
                    if (j == 1) { K = 512; ld = 512; S.coff = 128; S.tstep = 256u * 512u * 2u; S.s0 = pg8::mkseg((unsigned)WS_CSC, (unsigned)WS_PQTC, 1, 8, 0, 0, pg8::T_FOURC); S.s1 = none; }
                    if constexpr (q == 1 || q == 9 || q == 4) pg8::gemm_phase<pg8::EpiT, true>(F.lds, F.tid, K, ld, S, E); else pg8::gemm_phase<pg8::EpiT>(F.lds, F.tid, K, ld, S, E);
                }
                if (l0 && q == 1 && F.vcu >= 96) prep_items(p, F, 1, (F.vcu - 96) * 8 + F.wave, (F.G - 96) * 8);
                if (l0 && q == 5 && (F.vcu < 136 || F.vcu >= 232)) { const int wk = F.vcu < 136 ? F.vcu : 136 + (F.vcu - 232); prep_items(p, F, 3, wk * 8 + F.wave, 160 * 8); prep_items(p, F, 2, wk * 8 + F.wave, 160 * 8);
                    __syncthreads(); mod_table(p, F); for (int it = 288 + wk; it < 576; it += 160) mod_item(p, F, it); }
                if (q == 5) { for (int sid = F.vcu - 136; sid >= 0 && sid < 96; sid += F.G) gla_stream(p, F, sid); }
            } else if (q == 2 || q == 10 || q == 7) {
                const bool first = l0 && q == 2;
                const bool ctxp = !(!l0 && q != 2);
                const int K = (q == 7) ? D : FF;
                pg8::Sched S; S.nfull = 0; S.parts = 1; S.kpart = 0; S.kbase = 0; S.pbase = 0; S.G = F.G; S.vcu = F.vcu; S.coff = 0; S.tstep = 256u * (unsigned)K * 2u; S.ws = (const char*)F.ws;
                const pg8::Seg none{0u, 0u, 0u}; S.s1 = none; S.s2 = none;
                const unsigned Aoff = (unsigned)(q == 7 ? WS_A : WS_ACT), Boff = wl + (unsigned)(q == 2 ? W_F1O : q == 10 ? W_F2O : W_MO);
                S.s0 = pg8::mkseg(Aoff, Boff, 64, 4, 0, 0, 0);
                if constexpr (!l0 && (q == 7 || q == 10)) {
                    const pg8::EpiRN E{p.out, modl + (q == 7 ? 5 : 8) * D, p.out, p.final_norm, p.out, (bf16_t*)(F.ws + WS_A2), p.norm_ffn2 + l * D, modl + 6 * D,
                                       (float*)(F.ws + WS_XBUF) + (q == 7 ? 0 : NLAT * 4), (unsigned*)(F.ws + WS_XCNT) + (q == 7 ? 0 : 64 * 64), (q == 7) ? 1.0f : 0.5f, (q == 7) ? 1 : 0};
                    pg8::gemm_phase<pg8::EpiRN>(F.lds, F.tid, K, K, S, E);
                } else if constexpr (l0 && q == 7) {
                    const pg8::EpiRN E{p.out, modl + 5 * D, p.out, p.final_norm, p.out, (bf16_t*)(F.ws + WS_A2), p.norm_ffn2, modl + 6 * D,
                                       (float*)(F.ws + WS_XBUF) + NLAT * 4, (unsigned*)(F.ws + WS_XCNT) + 5 * 64 * 64, 1.0f, 1};
                    pg8::gemm_phase<pg8::EpiRN>(F.lds, F.tid, K, K, S, E);
                } else if constexpr (q == 2 || (l0 && q == 10)) {
                    constexpr int site = l0 ? (q == 2 ? 2 : 3) : 4;
                    const float* ngain = (q == 2) ? p.norm_mix + l * D : p.norm_ffn1 + D;
                    const float* nscsh = (q == 2) ? modl + 3 * D : F_MOD + (size_t)9 * (NMOD * D);
                    const pg8::EpiRN E{first ? p.x : p.out, modl + (q == 2 ? 2 : 8) * D, p.out, p.final_norm, p.out, (bf16_t*)(F.ws + WS_A), ngain, nscsh,
                                       (float*)(F.ws + WS_XBUF) + (site & 1) * NLAT * 4, (unsigned*)(F.ws + WS_XCNT) + site * 64 * 64, 0.5f, 1};
                    pg8::gemm_phase<pg8::EpiRN>(F.lds, F.tid, K, K, S, E);
                } else {
                pg8::EpiR E; E.in_lat = first ? p.x : p.out; E.in_ctx = first ? p.ctx : F_HC; E.out_lat = p.out; E.out_ctx = F_HC;
                E.gate = modl + (q == 2 ? 2 : q == 7 ? 5 : 8) * D; E.coef = (q == 7) ? 1.0f : 0.5f;
                pg8::gemm_phase<pg8::EpiR>(F.lds, F.tid, K, K, S, E);
                }
                if (ctxp) {
                    const pg8::EpiP EP{(bf16_t*)(F.ws + ((l0 && q == 7) ? WS_ACT : WS_PART))};
                    S.s0 = pg8::mkseg(Aoff, Boff, 8, 4, 64, 0, 0);
                    const bool j0 = F.vcu < 192;
                    if (q == 7) { S.parts = 8; S.kpart = 128; }
                    else { S.parts = j0 ? 6 : 2; S.kpart = j0 ? 384 : 256; S.kbase = j0 ? 0 : 2304; S.pbase = j0 ? 0 : 6; S.coff = j0 ? 0 : 192; }
                    pg8::gemm_phase<pg8::EpiP>(F.lds, F.tid, S.kpart, K, S, EP);
                }
            } else if (q == 5) {
                float a1 = p.lq1[F.lane] * p.lk1[F.lane], a2 = p.lq2[F.lane] * p.lk2[F.lane];
                a1 = wave_sum(a1); a2 = wave_sum(a2);
                const float lam = __expf(a1) - __expf(a2) + LAM_INIT;
                conv_part(p, F);
                for (int u = F.vcu; u < 768; u += F.G) attn_unit(p, F, u, lam);
            } else if (q == 6) {
                if (l0) combine_phase(p, F);
            }
        }
}

__global__ void __launch_bounds__(512, 2) fwd_kernel(Params p_arg) {
    extern __shared__ __attribute__((aligned(16))) unsigned char lds_raw[];
    cg::grid_group grid = cg::this_grid();
    volatile LAS unsigned* st_ = (volatile LAS unsigned*)((LAS unsigned char*)lds_raw + 131072);
    const int wave_s = __builtin_amdgcn_readfirstlane(threadIdx.x >> 6);
    if (threadIdx.x < 4) st_[threadIdx.x] = 0u;
    __syncthreads();
    if (p_arg.ph_lo < 0) grid.sync();
    XcdBarrier bar = xcd_barrier_post((unsigned*)(p_arg.ws + WS_BAR), st_, (wave_s == 0) && (__builtin_amdgcn_mbcnt_hi(~0u, __builtin_amdgcn_mbcnt_lo(~0u, 0u)) == 0));
#define RUN_PHASE(k) { \
        KParams* kp_ = (KParams*)__builtin_amdgcn_kernarg_segment_ptr(); asm volatile("" : "+s"(kp_)); PRef p = *kp_; \
        Frame F; F.lds = (LAS unsigned char*)lds_raw; \
        int w_ = wave_s; asm volatile("" : "+s"(w_)); int l_ = __builtin_amdgcn_mbcnt_hi(~0u, __builtin_amdgcn_mbcnt_lo(~0u, 0u)); asm volatile("" : "+v"(l_)); F.lane = l_; F.wave = w_; F.tid = w_ * 64 + l_; \
        int g_ = gridDim.x, bx_ = blockIdx.x; asm volatile("" : "+s"(g_), "+s"(bx_)); F.G = g_; F.vcu = (g_ % 8 == 0) ? (bx_ % 8) * (g_ / 8) + bx_ / 8 : bx_; \
        F.ws = p.ws; \
        run_phase<(k)>(p, F); }
#define SEAM() xcd_barrier(bar, (wave_s == 0) && (__builtin_amdgcn_mbcnt_hi(~0u, __builtin_amdgcn_mbcnt_lo(~0u, 0u)) == 0))
    RUN_PHASE(0) SEAM();
    RUN_PHASE(1) SEAM(); RUN_PHASE(2) SEAM(); RUN_PHASE(3) SEAM(); RUN_PHASE(4) SEAM(); RUN_PHASE(5) SEAM(); RUN_PHASE(6) SEAM(); RUN_PHASE(7) SEAM(); RUN_PHASE(8) SEAM();
    RUN_PHASE(9) SEAM(); RUN_PHASE(10) SEAM(); RUN_PHASE(11) SEAM(); RUN_PHASE(12) SEAM(); RUN_PHASE(13) SEAM(); RUN_PHASE(14) SEAM(); RUN_PHASE(15) SEAM(); RUN_PHASE(16) SEAM();
    RUN_PHASE(17) SEAM(); RUN_PHASE(19) SEAM(); RUN_PHASE(21) SEAM(); RUN_PHASE(22)
#undef RUN_PHASE
#undef SEAM
}

extern "C" void kernel_launch(void* const* d_in, const int* in_sizes, int n_in, void* d_out, int out_size, void* d_ws, size_t ws_size, hipStream_t stream) {
    static int grid_blocks = 0;
    if (grid_blocks == 0) {
        if (n_in != 27 || out_size != NLAT * D || ws_size < WS_END) { fprintf(stderr, "kernel_launch: unexpected problem (n_in %d out %d ws %zu, need %zu)\n", n_in, out_size, ws_size, (size_t)WS_END); grid_blocks = -1; return; }
        int dev = 0, cus = 0, per_cu = 0;
        hipGetDevice(&dev);
        hipDeviceGetAttribute(&cus, hipDeviceAttributeMultiprocessorCount, dev);
        hipFuncSetAttribute((const void*)fwd_kernel, hipFuncAttributeMaxDynamicSharedMemorySize, LDS_BYTES);
        hipOccupancyMaxActiveBlocksPerMultiprocessor(&per_cu, (const void*)fwd_kernel, 512, LDS_BYTES);
        if (per_cu < 1) { fprintf(stderr, "kernel_launch: occupancy query reports %d blocks per CU\n", per_cu); grid_blocks = -1; return; }
        grid_blocks = cus;
        if (grid_blocks < 256) { fprintf(stderr, "kernel_launch: needs >= 256 CUs, got %d\n", grid_blocks); grid_blocks = -1; return; }
    }
    if (grid_blocks < 0) return;
    if (hipMemsetAsync((char*)d_ws + WS_BAR, 0, (WS_XCNT - WS_BAR) + 6 * 64 * 256, stream) != hipSuccess) { fprintf(stderr, "kernel_launch: memset of the barrier words failed\n"); return; }
    Params p{};
    const float** pp = (const float**)&p;
    for (int i = 0; i < 27; ++i) pp[i] = (const float*)d_in[i];
    p.out = (float*)d_out; p.ws = (unsigned char*)d_ws; p.ph_lo = 0; p.ph_hi = 24;
    void* args[] = {&p};
    hipError_t e = hipLaunchCooperativeKernel((const void*)fwd_kernel, dim3(grid_blocks), dim3(512), args, LDS_BYTES, stream);
    if (e != hipSuccess) fprintf(stderr, "cooperative launch failed: %s (grid %d)\n", hipGetErrorString(e), grid_blocks);
}
```

```cpp
#include <hip/hip_runtime.h>
#include <hip/hip_cooperative_groups.h>
#include <cstdio>
#include <cstdint>
namespace cg = cooperative_groups;

#define LAS __attribute__((address_space(3)))
typedef unsigned short bf16_t;
typedef short bf16x8 __attribute__((ext_vector_type(8)));
typedef short s16x4 __attribute__((ext_vector_type(4)));
typedef float f32x4 __attribute__((ext_vector_type(4)));
typedef float f32x16 __attribute__((ext_vector_type(16)));
typedef unsigned u32x4 __attribute__((ext_vector_type(4)));
typedef unsigned u32x2 __attribute__((ext_vector_type(2)));

constexpr int D = 1024, NB = 8, TL = 2048, TC = 256, NLAT = NB * TL, NCTX = NB * TC, NROW = NLAT + NCTX;
constexpr int FF = 2816, NMOD = 9;
constexpr int EV_LD = 1792, OD_LD = 2304, KVT = TL + TC;
constexpr float EPS = 1e-6f;
constexpr float LAM_INIT = 0.35550906759f;
constexpr float QSCALE = 0.125f * 1.4426950408889634f;

constexpr size_t MiB = 1u << 20;
constexpr size_t WS_MOD = 0;
constexpr size_t WS_BAR = 768 * 1024;
constexpr size_t WS_ROPE = 1 * MiB;
constexpr size_t WS_CSC = 1 * MiB + 512 * 1024;
constexpr size_t WS_HC = 2 * MiB;
constexpr size_t WS_W0 = 10 * MiB;
constexpr size_t W_F1I = 0, W_F1O = 11 * MiB, W_F2I = 16 * MiB + 512 * 1024, W_F2O = 27 * MiB + 512 * 1024, W_MO = 33 * MiB, W_LAYER = 35 * MiB;
constexpr size_t WS_CS = WS_W0;
constexpr size_t WS_WEV = 80 * MiB;
constexpr size_t WS_WEVV = WS_WEV + 3 * MiB + 512 * 1024;
constexpr size_t WS_WPQ = 85 * MiB;
constexpr size_t WS_WOD = 86 * MiB;
constexpr size_t WS_WODV = WS_WOD + 4 * MiB + 512 * 1024;
constexpr size_t WS_A = 92 * MiB;
constexpr size_t WS_ACT = 128 * MiB;
constexpr size_t WS_OF = 191 * MiB;
constexpr size_t WS_FP1 = 218 * MiB;
constexpr size_t WS_VT = 227 * MiB;
constexpr size_t WS_PQT = 254 * MiB;
constexpr size_t WS_PQTC = 270 * MiB;
constexpr size_t WS_OB = 272 * MiB;
constexpr size_t WS_PART = 227 * MiB;
constexpr size_t WS_XCNT = 800 * 1024;
constexpr size_t WS_XBUF = 299 * MiB;
constexpr size_t WS_A2 = 227 * MiB;
constexpr size_t WS_END = 300 * MiB;

constexpr int LDS_BYTES = 131072 + 1024;

struct Params {
    const float *x, *c, *ctx, *c_ctx, *ada_w, *ada_b, *norm_ffn1, *norm_mix, *norm_ffn2, *ffn1_w_in, *ffn1_w_out, *ffn2_w_in, *ffn2_w_out,
        *mix_w_out, *even_w_in, *gla_gate_w, *gla_gate_b, *gla_norm, *odd_w_in, *conv_w, *conv_b, *lq1, *lk1, *lq2, *lk2, *diff_norm, *final_norm;
    float* out; unsigned char* ws; int ph_lo, ph_hi;
};

typedef const __attribute__((address_space(4))) Params KParams;
typedef KParams& PRef;
__device__ __forceinline__ float bf2f(unsigned h) { return __uint_as_float(h << 16); }
typedef float f32x2_t __attribute__((ext_vector_type(2))); typedef __bf16 bf16x2_t __attribute__((ext_vector_type(2)));
__device__ __forceinline__ unsigned cvt_pk_bf16(float lo, float hi) { f32x2_t v = {lo, hi}; bf16x2_t b = __builtin_convertvector(v, bf16x2_t); return __builtin_bit_cast(unsigned, b); }
__device__ __forceinline__ unsigned f2bf(float f) { return cvt_pk_bf16(f, 0.f) & 0xffffu; }
__device__ __forceinline__ unsigned pk2(float lo, float hi) { return cvt_pk_bf16(lo, hi); }
__device__ __forceinline__ float silu_f(float x) { return x / (1.0f + __expf(-x)); }
__device__ __forceinline__ float wave_sum(float v) {
#pragma unroll
    for (int o = 1; o < 64; o <<= 1) v += __shfl_xor(v, o);
    return v;
}
#define DPPF(x, ctrl, rm, bm) __int_as_float(__builtin_amdgcn_update_dpp(0, __float_as_int(x), ctrl, rm, bm, false))
#define MFMA16(a, b, c) __builtin_amdgcn_mfma_f32_16x16x32_bf16(a, b, c, 0, 0, 0)
#define MFMA32(a, b, c) __builtin_amdgcn_mfma_f32_32x32x16_bf16(a, b, c, 0, 0, 0)

namespace pg8 {
constexpr int BM = 256, BK = 64, HALF = 128, HTB = HALF * BK * 2, STAGE_BYTES = 8 * HTB;
__device__ __forceinline__ int lds_byte(int r, int c) { const int st = (r >> 4) * 2 + (c >> 5), rr = r & 15, cc = c & 31, ob = rr * 64 + cc * 2; return st * 1024 + (ob ^ (((ob >> 9) & 1) << 5)); }
__device__ __forceinline__ void stage_rc(int b, int& R, int& C) { const int st = b / 1024, sb = b % 1024, swz = sb ^ (((sb >> 9) & 1) << 5); R = (st >> 1) * 16 + swz / 64; C = (st & 1) * 32 + (swz % 64) / 2; }
__device__ __forceinline__ int perm32(int rho) { const int n = rho >> 4, i = rho & 15; return 8 * (i >> 2) + 4 * n + (i & 3); }

struct Unit { const char* a; const char* b; int pm, pn, tag, half; };
struct Seg { unsigned A, B, dims; };
__device__ __forceinline__ Seg mkseg(unsigned A, unsigned B, int nM, int nN, int pm0, int pn0, int tag) { Seg s; s.A = A; s.B = B; s.dims = (unsigned)nM | ((unsigned)nN << 8) | ((unsigned)pm0 << 16) | ((unsigned)pn0 << 24) | ((unsigned)tag << 28); return s; }
struct Sched {
    Seg s0, s1, s2; int G, vcu, coff; unsigned tstep; const char* ws;
    int nfull;
    int parts, kpart, kbase, pbase;
    __device__ __forceinline__ bool dec(const Seg& s, int& L, Unit& u) const {
        const int nM = s.dims & 255, nN = (s.dims >> 8) & 255;
        const int n = nM * nN;
        if (L < n) {
            const int idx = L, nig = 8 * nN, gid = idx / nig, fm = gid * 8, gsz = (nM - fm) < 8 ? (nM - fm) : 8;
            const int pm = fm + ((idx % nig) % gsz), pn = (idx % nig) / gsz;
            u.pm = (int)((s.dims >> 16) & 255) + pm; u.pn = (int)((s.dims >> 24) & 15) + pn; u.tag = (int)(s.dims >> 28); u.a = ws + s.A + (size_t)u.pm * tstep; u.b = ws + s.B + (size_t)u.pn * tstep; return true;
        }
        L -= n; return false;
    }
    __device__ __forceinline__ bool next(int i, Unit& u) const {
        int L = i * G + vcu - coff; if (L < 0) return false;
        u.half = 0; int hsel = -1;
        if (nfull > 0 && L >= nfull) { const int hl = L - nfull; hsel = hl & 1; L = nfull + (hl >> 1); }
        if (parts > 1) { const int part = L % parts; L /= parts; if (!dec(s0, L, u)) return false;
            const size_t ko = (size_t)(kbase + part * kpart) * 2; u.a += ko; u.b += ko; u.tag = pbase + part; return true; }
        if (!(dec(s0, L, u) || dec(s1, L, u) || dec(s2, L, u))) return false;
        if (hsel >= 0) { u.half = 1 + hsel; u.a += (size_t)hsel * (tstep >> 1); }
        return true;
    }
};

enum { T_SWIGLU = 0, T_ZEV = 1, T_ZODD = 2, T_TRV = 3, T_TRPQ = 4, T_FOUR = 5, T_FOURC = 6, T_FOUR2 = 7 };
struct EpiT {
    static constexpr bool PERM = true, AFTER_DRAIN = false;
    unsigned char* ws; unsigned dst_off; int ldc;
    __device__ __forceinline__ void operator()(const f32x4 (&acc)[2][2][4][2], const Unit& u, int wr, int wc, int fr, int fq) const {
        bf16_t* dst = (bf16_t*)(ws + dst_off); bf16_t* vt = (bf16_t*)(ws + WS_VT); bf16_t* pqt = (bf16_t*)(ws + WS_PQT); bf16_t* pqtc = (bf16_t*)(ws + WS_PQTC); const float* rope = (const float*)(ws + WS_ROPE);
        const int lr0 = wr * 64 + fr;
        const int lc0 = wc * 32 + 8 * fq;
        if (u.tag == T_SWIGLU) {
            const int rsh = (u.half == 2) ? HALF : 0;
#pragma unroll
            for (int ai = 0; ai < 2; ++ai)
#pragma unroll
                for (int m = 0; m < 4; ++m) {
                    if (ai == 1 && u.half != 0) continue;
                    bf16_t* rowp = dst + (size_t)(u.pm * BM + rsh + lr0 + ai * HALF + m * 16) * ldc + u.pn * HALF + lc0;
                    float o[8];
#pragma unroll
                    for (int n = 0; n < 2; ++n)
#pragma unroll
                        for (int e = 0; e < 4; e += 2) {
                            const f32x2_t g2 = (f32x2_t){acc[ai][0][m][n][e], acc[ai][0][m][n][e + 1]}, u2 = (f32x2_t){acc[ai][1][m][n][e], acc[ai][1][m][n][e + 1]};
                            const f32x2_t t2 = g2 * -1.4426950408889634f; const f32x2_t d2 = (f32x2_t){__builtin_amdgcn_exp2f(t2.x), __builtin_amdgcn_exp2f(t2.y)} + 1.0f;
                            const f32x2_t r2 = (g2 * u2) * (f32x2_t){__builtin_amdgcn_rcpf(d2.x), __builtin_amdgcn_rcpf(d2.y)}; o[n * 4 + e] = r2.x; o[n * 4 + e + 1] = r2.y; }
                    u32x4 w; w.x = cvt_pk_bf16(o[0], o[1]); w.y = cvt_pk_bf16(o[2], o[3]); w.z = cvt_pk_bf16(o[4], o[5]); w.w = cvt_pk_bf16(o[6], o[7]);
                    *(u32x4*)rowp = w;
                    asm volatile("" ::: "memory");
                }
        } else if (u.tag == T_ZEV || u.tag == T_ZODD || u.tag == T_FOUR || u.tag == T_FOURC || u.tag == T_FOUR2) {
            float sc = 1.f; bool rp = false; size_t rbase; int cbase = u.pn * BM; int ldo = ldc;
            if (u.tag == T_ZODD) { rbase = (size_t)u.pm * BM; if (u.pn >= 3 && u.pn < 6) sc = QSCALE; rp = (u.pn >= 3) && (u.pm < 64); }
            else if (u.tag == T_ZEV) rbase = (size_t)u.pm * BM;
            else if (u.tag == T_FOUR) { rbase = (size_t)u.pn * TL + (size_t)u.pm * BM; cbase = 0; sc = 0.00276213586400995f; }
            else if (u.tag == T_FOUR2) { rbase = (size_t)u.pn * TL + (size_t)u.pm * BM; cbase = 0; sc = 0.00276213586400995f; dst = (bf16_t*)(ws + WS_FP1); ldo = 256; }
            else { rbase = (size_t)NLAT + (size_t)u.pn * TC; cbase = 0; sc = 0.0078125f; }
#pragma unroll
            for (int ai = 0; ai < 2; ++ai)
#pragma unroll
                for (int m = 0; m < 4; ++m) {
                    if (ai == 1 && u.half != 0) continue;
                    const size_t row = rbase + ((u.half == 2) ? HALF : 0) + lr0 + ai * HALF + m * 16;
                    bf16_t* rowp = dst + row * ldo + cbase + lc0;
                    f32x4 cs[2], sn[2];
                    if (rp) {
                        const int t = (int)(row & (TL - 1)); const float* rt = rope + t * 64 + (wc & 1) * 16 + 8 * (fq & 1);
                        cs[0] = *(const f32x4*)(rt); cs[1] = *(const f32x4*)(rt + 4); sn[0] = *(const f32x4*)(rt + 32); sn[1] = *(const f32x4*)(rt + 36);
                    }
#pragma unroll
                    for (int bj = 0; bj < 2; ++bj) {
                        float o[8];
#pragma unroll
                        for (int n = 0; n < 2; ++n)
#pragma unroll
                            for (int e = 0; e < 4; ++e) {
                                float v = acc[ai][bj][m][n][e];
                                if (rp) { const float pv = __shfl_xor(v, 32); const float sg = (fq < 2) ? -sn[n][e] : sn[n][e]; v = v * cs[n][e] + pv * sg; }
                                o[n * 4 + e] = v * sc;
                            }
                        u32x4 w; w.x = cvt_pk_bf16(o[0], o[1]); w.y = cvt_pk_bf16(o[2], o[3]); w.z = cvt_pk_bf16(o[4], o[5]); w.w = cvt_pk_bf16(o[6], o[7]);
                        *(u32x4*)(rowp + bj * HALF) = w;
                    }
                    asm volatile("" ::: "memory");
                }
        } else {
            const bool lat = u.pn < 64; const int b = lat ? (u.pn >> 3) : (u.pn - 64);
            bf16_t* base; size_t pitch; int k0;
            if (u.tag == T_TRV) { base = vt + (size_t)b * 768 * KVT + (size_t)(u.pm * BM) * KVT; pitch = KVT; k0 = lat ? (u.pn & 7) * 256 : TL; }
            else if (lat) { base = pqt + (size_t)b * 256 * 4096; pitch = 4096; k0 = u.pm * TL + (u.pn & 7) * 256; }
            else { base = pqtc + (size_t)b * 256 * 512; pitch = 512; k0 = u.pm * TC; }
#pragma unroll
            for (int ai = 0; ai < 2; ++ai)
#pragma unroll
                for (int m = 0; m < 4; ++m) {
                    if (ai == 1 && u.half != 0) continue;
                    bf16_t* rowp = base + (size_t)(((u.half == 2) ? HALF : 0) + lr0 + ai * HALF + m * 16) * pitch + k0 + lc0;
#pragma unroll
                    for (int bj = 0; bj < 2; ++bj) {
                        const f32x4 v0 = acc[ai][bj][m][0], v1 = acc[ai][bj][m][1];
                        u32x4 w; w.x = cvt_pk_bf16(v0[0], v0[1]); w.y = cvt_pk_bf16(v0[2], v0[3]); w.z = cvt_pk_bf16(v1[0], v1[1]); w.w = cvt_pk_bf16(v1[2], v1[3]);
                        *(u32x4*)(rowp + bj * HALF) = w;
                    }
                }
        }
    }
};
struct EpiR {
    static constexpr bool PERM = false, AFTER_DRAIN = false;
    const float* in_lat; const float* in_ctx; float* out_lat; float* out_ctx; const float* gate; float coef;
    __device__ __forceinline__ void operator()(const f32x4 (&acc)[2][2][4][2], const Unit& u, int wr, int wc, int fr, int fq) const {
        const bool lat = u.pm < 64; const int cond = lat ? (u.pm >> 3) : 8;
        const float* ib = lat ? in_lat + (size_t)u.pm * BM * D : in_ctx + (size_t)(u.pm - 64) * BM * D;
        float* ob = lat ? out_lat + (size_t)u.pm * BM * D : out_ctx + (size_t)(u.pm - 64) * BM * D;
        const int col0 = u.pn * BM + wc * 32 + 4 * fq; const float* gp = gate + (size_t)cond * (NMOD * D) + col0;
        f32x4 gv[2][2];
#pragma unroll
        for (int bj = 0; bj < 2; ++bj)
#pragma unroll
            for (int n = 0; n < 2; ++n) gv[bj][n] = *(const f32x4*)(gp + bj * HALF + n * 16) * coef;
#pragma unroll
        for (int ai = 0; ai < 2; ++ai)
#pragma unroll
            for (int m = 0; m < 4; ++m) {
                const size_t off = (size_t)(ai * HALF + wr * 64 + m * 16 + fr) * D + col0;
#pragma unroll
                for (int bj = 0; bj < 2; ++bj)
#pragma unroll
                    for (int n = 0; n < 2; ++n) { const f32x4 hv = *(const f32x4*)(ib + off + bj * HALF + n * 16); *(f32x4*)(ob + off + bj * HALF + n * 16) = hv + gv[bj][n] * acc[ai][bj][m][n]; }
            }
    }
};

struct EpiP {
    static constexpr bool PERM = false, AFTER_DRAIN = false;
    bf16_t* P;
    __device__ __forceinline__ void operator()(const f32x4 (&acc)[2][2][4][2], const Unit& u, int wr, int wc, int fr, int fq) const {
        int fr_ = fr, fq_ = fq; asm volatile("" : "+v"(fr_), "+v"(fq_));
        bf16_t* base = P + ((size_t)u.tag * NCTX + (size_t)(u.pm - 64) * BM) * D + u.pn * BM + wc * 32 + 4 * fq_;
#pragma unroll
        for (int ai = 0; ai < 2; ++ai)
#pragma unroll
            for (int m = 0; m < 4; ++m) {
                bf16_t* rp = base + (size_t)(ai * HALF + wr * 64 + m * 16 + fr_) * D;
#pragma unroll
                for (int bj = 0; bj < 2; ++bj)
#pragma unroll
                    for (int n = 0; n < 2; ++n) { const f32x4 v = acc[ai][bj][m][n]; u32x2 w; w.x = cvt_pk_bf16(v[0], v[1]); w.y = cvt_pk_bf16(v[2], v[3]); *(u32x2*)(rp + bj * HALF + n * 16) = w; }
            }
    }
};

struct EpiRN {
    static constexpr bool PERM = false, AFTER_DRAIN = true;
    const float* in; const float* gate; float* outf; const float* gfin;
    float* hout; bf16_t* aout; const float* gain; const float* scsh;
    float* xbuf; unsigned* cnt; float coef; int mode;
    __device__ __forceinline__ void fused(f32x4 (&acc)[2][2][4][2], const Unit& u, int wr, int wc, int fr, int fq, LAS unsigned char* lds, int wid, int lane) const {
        LAS float* P = (LAS float*)lds;
        LAS float* S = (LAS float*)(lds + 4096);
        const int cond = u.pm >> 3;
        const int col0 = u.pn * BM + wc * 32 + 4 * fq;
        const float* ib = in + (size_t)u.pm * BM * D;
        const float* gp = gate + (size_t)cond * (NMOD * D) + col0;
        f32x4 gv[2][2];
#pragma unroll
        for (int bj = 0; bj < 2; ++bj)
#pragma unroll
            for (int n = 0; n < 2; ++n) gv[bj][n] = *(const f32x4*)(gp + bj * HALF + n * 16) * coef;
#pragma unroll
        for (int ai = 0; ai < 2; ++ai)
#pragma unroll
            for (int m = 0; m < 4; ++m) {
                const int lrow = ai * HALF + wr * 64 + m * 16 + fr; const size_t off = (size_t)lrow * D + col0; float ss = 0.f;
#pragma unroll
                for (int bj = 0; bj < 2; ++bj)
#pragma unroll
                    for (int n = 0; n < 2; ++n) { const f32x4 hn = *(const f32x4*)(ib + off + bj * HALF + n * 16) + gv[bj][n] * acc[ai][bj][m][n]; acc[ai][bj][m][n] = hn;
                        ss += (hn[0] * hn[0] + hn[1] * hn[1]) + (hn[2] * hn[2] + hn[3] * hn[3]); }
                ss += __shfl_xor(ss, 16); ss += __shfl_xor(ss, 32);
                if (fq == 0) P[lrow * 4 + wc] = ss;
                if (m & 1) asm volatile("" ::: "memory");
            }
        __syncthreads();
        const int row = wid * 32 + (lane & 31);
        float* slot = xbuf + ((size_t)(u.pm * BM + row) * 4);
        if (lane < 32) { const float t = (P[row * 4 + 0] + P[row * 4 + 1]) + (P[row * 4 + 2] + P[row * 4 + 3]);
            __hip_atomic_store(slot + u.pn, t, __ATOMIC_RELAXED, __HIP_MEMORY_SCOPE_AGENT); }
        asm volatile("s_waitcnt vmcnt(0)" ::: "memory");
        if (lane == 0) __hip_atomic_fetch_add(cnt + 64 * u.pm, 1u, __ATOMIC_RELAXED, __HIP_MEMORY_SCOPE_AGENT);
        if (wid == 0) {
            unsigned sp = 0;
            while ((unsigned)__builtin_amdgcn_readfirstlane(__hip_atomic_load(cnt + 64 * u.pm, __ATOMIC_RELAXED, __HIP_MEMORY_SCOPE_AGENT)) < 32u) { __builtin_amdgcn_s_sleep(2); if (++sp > (1u << 22)) break; }
            __builtin_amdgcn_fence(__ATOMIC_ACQUIRE, "agent");
        }
        asm volatile("s_waitcnt vmcnt(0) lgkmcnt(0)" ::: "memory");
        __syncthreads();
        if (lane < 32) { float q = 0.f;
#pragma unroll
            for (int t = 0; t < 4; ++t) q += __hip_atomic_load(slot + t, __ATOMIC_RELAXED, __HIP_MEMORY_SCOPE_AGENT);
            S[row] = rsqrtf(q * (1.f / D) + EPS); }
        __syncthreads();
        f32x4 g0[2][2], g1[2][2];
#pragma unroll
        for (int bj = 0; bj < 2; ++bj)
#pragma unroll
            for (int n = 0; n < 2; ++n) { const int c = col0 + bj * HALF + n * 16;
                if (mode == 0) { g0[bj][n] = *(const f32x4*)(gfin + c); g1[bj][n] = (f32x4){0.f, 0.f, 0.f, 0.f}; }
                else { const float* sp_ = scsh + (size_t)cond * (NMOD * D) + c; g0[bj][n] = *(const f32x4*)(gain + c) * (*(const f32x4*)(sp_ + D) + 1.0f); g1[bj][n] = *(const f32x4*)(sp_); } }
#pragma unroll
        for (int ai = 0; ai < 2; ++ai)
#pragma unroll
            for (int m = 0; m < 4; ++m) {
                const int lrow = ai * HALF + wr * 64 + m * 16 + fr; const size_t off = (size_t)(u.pm * BM + lrow) * D + col0; const float rs = S[lrow];
#pragma unroll
                for (int bj = 0; bj < 2; ++bj)
#pragma unroll
                    for (int n = 0; n < 2; ++n) { const f32x4 hn = acc[ai][bj][m][n]; const f32x4 y = (hn * rs) * g0[bj][n] + g1[bj][n];
                        if (mode == 0) *(f32x4*)(outf + off + bj * HALF + n * 16) = y;
                        else { *(f32x4*)(hout + off + bj * HALF + n * 16) = hn; u32x2 w; w.x = cvt_pk_bf16(y[0], y[1]); w.y = cvt_pk_bf16(y[2], y[3]); *(u32x2*)(aout + off + bj * HALF + n * 16) = w; } }
                if (m & 1) asm volatile("" ::: "memory");
            }
    }
};

template <class Epi, bool HM = false>
__device__ __forceinline__ void gemm_phase(LAS unsigned char* lds, const int tid, const int K, const int ld, const Sched& S, const Epi& E) {
    const int wid = __builtin_amdgcn_readfirstlane(tid >> 6), lane = tid & 63, wr = wid >> 2, wc = wid & 3, fr = lane & 15, fq = lane >> 4;
    const int nt = K / BK;
    unsigned voffA[2], voffB[2];
#pragma unroll
    for (int i = 0; i < 2; ++i) { int R, C; stage_rc(tid * 16 + i * 8192, R, C); const int Rb = Epi::PERM ? ((R & ~31) + perm32(R & 31)) : R;
        voffA[i] = (unsigned)(R * ld + C) * 2u; voffB[i] = (unsigned)(Rb * ld + C) * 2u; }
    const size_t kstep = (size_t)(BK * 2);
    const size_t hstep = (size_t)HALF * ld * 2;
    const unsigned ldsw = (unsigned)wid * 1024u;
    const int aoff = lds_byte(wr * 64 + fr, fq * 8), boff = lds_byte(wc * 32 + fr, fq * 8);
#define PG8_SA(b, h) (((b) * 2 + (h)) * HTB)
#define PG8_SB(b, h) ((4 + (b) * 2 + (h)) * HTB)
#define PG8_STAGE(bufoff, gbase, voff) do { _Pragma("unroll") for (int _i = 0; _i < 2; ++_i) \
        __builtin_amdgcn_global_load_lds((const unsigned*)((const char*)(gbase) + (voff)[_i]), (LAS unsigned*)(lds + (bufoff) + ldsw + _i * 8192), 16, 0, 0); } while (0)
#define PG8_LDA(dst, b, h) do { _Pragma("unroll") for (int m = 0; m < 4; ++m) _Pragma("unroll") for (int k = 0; k < 2; ++k) dst[m][k] = *(const LAS bf16x8*)(lds + PG8_SA(b, h) + aoff + m * 2048 + k * 1024); } while (0)
#define PG8_LDB(dst, b, h) do { _Pragma("unroll") for (int n = 0; n < 2; ++n) _Pragma("unroll") for (int k = 0; k < 2; ++k) dst[n][k] = *(const LAS bf16x8*)(lds + PG8_SB(b, h) + boff + n * 2048 + k * 1024); } while (0)
#define PG8_MMA(ai, bj, At, Bt) do { __builtin_amdgcn_s_setprio(1); _Pragma("unroll") for (int m = 0; m < 4; ++m) _Pragma("unroll") for (int n = 0; n < 2; ++n) _Pragma("unroll") for (int k = 0; k < 2; ++k) \
        acc[ai][bj][m][n] = __builtin_amdgcn_mfma_f32_16x16x32_bf16(Bt[n][k], At[m][k], acc[ai][bj][m][n], 0, 0, 0); __builtin_amdgcn_s_setprio(0); } while (0)
#define PG8_WAIT_V(n) asm volatile("s_waitcnt vmcnt(" #n ")" ::: "memory")
#define PG8_WAIT_L(n) asm volatile("s_waitcnt lgkmcnt(" #n ")" ::: "memory")
#define PG8_BAR __builtin_amdgcn_s_barrier()
#define PG8_SCHED __builtin_amdgcn_sched_barrier(0)
    Unit cur, nxt; int ui = 0;
    if (!S.next(0, cur)) return;
    f32x4 acc[2][2][4][2];
#pragma unroll
    for (int a = 0; a < 2; ++a)
#pragma unroll
        for (int b = 0; b < 2; ++b)
#pragma unroll
            for (int m = 0; m < 4; ++m)
#pragma unroll
                for (int n = 0; n < 2; ++n) acc[a][b][m][n] = (f32x4){0.f, 0.f, 0.f, 0.f};
    bf16x8 At[4][2], B0[2][2], B1[2][2];
    const char* cA = cur.a; const char* cB = cur.b;
    PG8_STAGE(PG8_SB(0, 0), cB, voffB); PG8_STAGE(PG8_SB(0, 1), cB + hstep, voffB); PG8_STAGE(PG8_SA(0, 0), cA, voffA); PG8_STAGE(PG8_SA(0, 1), cA + hstep, voffA);
    if (wr == 1) PG8_BAR;
    PG8_WAIT_V(2); PG8_BAR;
    PG8_STAGE(PG8_SB(1, 0), cB + kstep, voffB); PG8_STAGE(PG8_SA(1, 0), cA + kstep, voffA); PG8_STAGE(PG8_SB(1, 1), cB + hstep + kstep, voffB);
    PG8_WAIT_V(6); PG8_BAR;
    for (;;) {
        const bool hm = HM && (cur.half != 0);
        const bool has_next = S.next(ui + 1, nxt);
        const char* nA = has_next ? nxt.a : cA; const char* nB = has_next ? nxt.b : cB;
        for (int t = 0; t < nt; t += 2) {
            const bool last = (t == nt - 2);
            const char* a1 = cA + (size_t)(t + 1) * kstep;
            const char* a2 = last ? nA : cA + (size_t)(t + 2) * kstep; const char* b2 = last ? nB : cB + (size_t)(t + 2) * kstep;
            const char* a3 = a2 + kstep; const char* b3 = b2 + kstep;
            PG8_LDB(B0, 0, 0); PG8_LDB(B1, 0, 1); PG8_SCHED; PG8_LDA(At, 0, 0); PG8_STAGE(PG8_SA(1, 1), a1 + hstep, voffA);
            PG8_WAIT_V(8); PG8_WAIT_L(0); PG8_BAR; PG8_MMA(0, 0, At, B0); PG8_MMA(0, 1, At, B1); PG8_BAR; PG8_SCHED;
            if (!HM || !hm) PG8_LDA(At, 0, 1); PG8_STAGE(PG8_SB(0, 0), b2, voffB); PG8_STAGE(PG8_SB(0, 1), b2 + hstep, voffB); PG8_STAGE(PG8_SA(0, 0), a2, voffA);
            PG8_WAIT_V(8); PG8_WAIT_L(0); PG8_BAR; if (!HM || !hm) { PG8_MMA(1, 0, At, B0); PG8_MMA(1, 1, At, B1); } PG8_BAR; PG8_SCHED;
            PG8_LDB(B0, 1, 0); PG8_LDB(B1, 1, 1); PG8_SCHED; PG8_LDA(At, 1, 0); PG8_STAGE(PG8_SA(0, 1), a2 + hstep, voffA);
            PG8_WAIT_V(8); PG8_WAIT_L(0); PG8_BAR; PG8_MMA(0, 0, At, B0); PG8_MMA(0, 1, At, B1); PG8_BAR; PG8_SCHED;
            if (!HM || !hm) PG8_LDA(At, 1, 1); PG8_STAGE(PG8_SB(1, 0), b3, voffB); PG8_STAGE(PG8_SB(1, 1), b3 + hstep, voffB); PG8_STAGE(PG8_SA(1, 0), a3, voffA);
            PG8_WAIT_V(8); PG8_WAIT_L(0); PG8_BAR; if (!HM || !hm) { PG8_MMA(1, 0, At, B0); PG8_MMA(1, 1, At, B1); } PG8_BAR; PG8_SCHED;
        }
        if (wr == 0) PG8_BAR;
        if constexpr (!Epi::AFTER_DRAIN) E(acc, cur, wr, wc, fr, fq);
        if (!has_next) break;
#pragma unroll
        for (int a = 0; a < 2; ++a)
#pragma unroll
            for (int b = 0; b < 2; ++b)
#pragma unroll
                for (int m = 0; m < 4; ++m)
#pragma unroll
                    for (int n = 0; n < 2; ++n) acc[a][b][m][n] = (f32x4){0.f, 0.f, 0.f, 0.f};
        cur = nxt; cA = nA; cB = nB; ++ui;
        if (wr == 1) PG8_BAR;
    }
    PG8_WAIT_V(0);
    PG8_BAR;
    if constexpr (Epi::AFTER_DRAIN) E.fused(acc, cur, wr, wc, fr, fq, lds, wid, lane);
#undef PG8_SA
#undef PG8_SB
#undef PG8_STAGE
#undef PG8_LDA
#undef PG8_LDB
#undef PG8_MMA
#undef PG8_WAIT_V
#undef PG8_WAIT_L
#undef PG8_BAR
#undef PG8_SCHED
}
}

struct Frame {
    LAS unsigned char* lds; int tid, lane, wave, vcu, G;
    unsigned char* ws;
};
#define F_MOD ((float*)(F.ws + WS_MOD))
#define F_ROPE ((float*)(F.ws + WS_ROPE))
#define F_HC ((float*)(F.ws + WS_HC))
#define F_ABUF ((bf16_t*)(F.ws + WS_A))
#define F_ACT ((bf16_t*)(F.ws + WS_ACT))
#define F_VT ((bf16_t*)(F.ws + WS_VT))
#define F_PQT ((bf16_t*)(F.ws + WS_PQT))
#define F_PQTC ((bf16_t*)(F.ws + WS_PQTC))
#define F_OF ((bf16_t*)(F.ws + WS_OF))
#define F_OB ((bf16_t*)(F.ws + WS_OB))
#define F_CS ((bf16_t*)(F.ws + WS_CS))
#define F_CSC ((bf16_t*)(F.ws + WS_CSC))

__device__ __forceinline__ void mod_table(PRef p, Frame& F) {
    LAS float* sl = (LAS float*)F.lds;
    for (int i = F.tid; i < 9 * 1024; i += 512) { const int cond = i >> 10, k = i & 1023; const float v = cond < 8 ? p.c[cond * 1024 + k] : p.c_ctx[k]; sl[i] = silu_f(v); }
    __syncthreads();
}
__device__ __forceinline__ void mod_item(PRef p, Frame& F, int item) {
    LAS float* sl = (LAS float*)F.lds;
    LAS float* red = sl + 9 * 1024;
    const int l = item / 288, cb = item % 288, tid = F.tid;
    const int cq = tid & 7, kq = tid >> 3;
    const float* W = p.ada_w + (size_t)l * D * (NMOD * D) + 32 * cb + 4 * cq;
    f32x4 acc[9];
#pragma unroll
    for (int j = 0; j < 9; ++j) acc[j] = (f32x4){0.f, 0.f, 0.f, 0.f};
#pragma unroll 4
    for (int kk = 0; kk < 16; ++kk) {
        const int k = kq * 16 + kk; const f32x4 w = *(const f32x4*)(W + (size_t)k * (NMOD * D));
#pragma unroll
        for (int j = 0; j < 9; ++j) acc[j] += w * sl[j * 1024 + k];
    }
#pragma unroll
    for (int j = 0; j < 9; ++j)
#pragma unroll
        for (int e = 0; e < 4; ++e) red[(kq * 9 + j) * 32 + 4 * cq + e] = acc[j][e];
    __syncthreads();
    if (tid < 9 * 32) {
        const int j = tid >> 5, cc = tid & 31; float s = 0.f;
#pragma unroll 8
        for (int q = 0; q < 64; ++q) s += red[(q * 9 + j) * 32 + cc];
        F_MOD[(size_t)(l * 9 + j) * (NMOD * D) + 32 * cb + cc] = s + p.ada_b[l * (NMOD * D) + 32 * cb + cc];
    }
    __syncthreads();
}
__device__ __forceinline__ void tr_item(const float* W, int N, int K, int k0, int n0, bf16_t* drow, LAS float* scr, int lane) {
#pragma unroll 8
    for (int i = 0; i < 32; ++i) { const int kk = 2 * i + (lane >> 5); scr[kk * 33 + (lane & 31)] = W[(size_t)(k0 + kk) * N + n0 + (lane & 31)]; }
    asm volatile("s_waitcnt lgkmcnt(0)" ::: "memory");
    const int c = lane & 7;
#pragma unroll
    for (int j = 0; j < 4; ++j) { const int n = (lane >> 3) + 8 * j; const LAS float* s = scr + (8 * c) * 33 + n;
        u32x4 o; o.x = pk2(s[0 * 33], s[1 * 33]); o.y = pk2(s[2 * 33], s[3 * 33]); o.z = pk2(s[4 * 33], s[5 * 33]); o.w = pk2(s[6 * 33], s[7 * 33]);
        *(u32x4*)(drow + (size_t)n * K + k0 + 8 * c) = o; }
    asm volatile("s_waitcnt lgkmcnt(0)" ::: "memory");
}
__device__ __forceinline__ int ffn_in_row(int n0) { return n0 < FF ? (n0 / 128) * 256 + (n0 % 128) : ((n0 - FF) / 128) * 256 + 128 + ((n0 - FF) % 128); }

__device__ __forceinline__ void prep_items(PRef p, Frame& F, const int mode, const int gw, const int NGW) {
    LAS float* scr = (LAS float*)(F.lds + F.wave * 16384);
    const int lane = F.lane;
    constexpr int I_FI = 16 * 176, I_FO = 44 * 32, I_MO = 16 * 32, I_L = 2 * I_FI + 2 * I_FO + I_MO, I_EV = 16 * 73, I_OD = 16 * 96, I_FOLD = 256;
    constexpr int NITEMS = 2 * I_L + I_EV + I_OD + I_FOLD, NEARLY = I_FI + I_FO;
    constexpr int A2 = I_FO + I_MO, NA = I_FO + I_EV + I_FOLD, NB = I_FI + I_L + I_OD;
    const int nit = mode == 0 ? I_FI : mode == 1 ? NA : mode == 3 ? A2 : NB;
    for (int it = gw; it < nit; it += NGW) {
        int r;
        if (mode == 0) r = it;
        else if (mode == 1) r = it < I_FO ? 2 * I_FI + it : it < I_FO + I_EV ? 2 * I_L + (it - I_FO) : 2 * I_L + I_EV + I_OD + (it - I_FO - I_EV);
        else if (mode == 3) r = 2 * I_FI + I_FO + it;
        else r = it < I_FI ? I_FI + it : it < I_FI + I_L ? I_L + (it - I_FI) : 2 * I_L + I_EV + (it - I_FI - I_L);
        if (r < 2 * I_L) {
            const int l = r / I_L; r -= l * I_L; unsigned char* wl = F.ws + WS_W0 + (size_t)l * W_LAYER;
            if (r < 2 * I_FI) { const int which = r / I_FI; r -= which * I_FI; const int kb = r / 176, nb = r % 176;
                const float* W = (which ? p.ffn2_w_in : p.ffn1_w_in) + (size_t)l * D * 2 * FF; bf16_t* dst = (bf16_t*)(wl + (which ? W_F2I : W_F1I));
                tr_item(W, 2 * FF, D, kb * 64, nb * 32, dst + (size_t)ffn_in_row(nb * 32) * D, scr, lane); continue; }
            r -= 2 * I_FI;
            if (r < 2 * I_FO) { const int which = r / I_FO; r -= which * I_FO; const int kb = r / 32, nb = r % 32;
                const float* W = (which ? p.ffn2_w_out : p.ffn1_w_out) + (size_t)l * FF * D; bf16_t* dst = (bf16_t*)(wl + (which ? W_F2O : W_F1O));
                tr_item(W, D, FF, kb * 64, nb * 32, dst + (size_t)(nb * 32) * FF, scr, lane); continue; }
            r -= 2 * I_FO;
            { const int kb = r / 32, nb = r % 32; const float* W = p.mix_w_out + (size_t)l * D * D; bf16_t* dst = (bf16_t*)(wl + W_MO);
              tr_item(W, D, D, kb * 64, nb * 32, dst + (size_t)(nb * 32) * D, scr, lane); continue; }
        }
        r -= 2 * I_L;
        if (r < I_EV) { const int kb = r / 73, nb = 8 + r % 73, n0 = nb * 32; bf16_t* drow;
            bf16_t* wev = (bf16_t*)(F.ws + WS_WEV); bf16_t* wevv = (bf16_t*)(F.ws + WS_WEVV);
            if (n0 < 640) drow = wev + (size_t)(n0 - 256) * D;
            else if (n0 < 1024) drow = wev + (size_t)(384 + n0 - 640) * D;
            else if (n0 < 1792) drow = wevv + (size_t)(n0 - 1024) * D;
            else if (n0 < 2560) drow = wev + (size_t)(768 + n0 - 1792) * D;
            else drow = wev + (size_t)(1536 + n0 - 2560) * D;
            tr_item(p.even_w_in, 2592, D, kb * 64, n0, drow, scr, lane); continue; }
        r -= I_EV;
        if (r < I_OD) { const int kb = r / 96, nb = r % 96, n0 = nb * 32;
            bf16_t* drow = n0 < 2304 ? (bf16_t*)(F.ws + WS_WOD) + (size_t)n0 * D : (bf16_t*)(F.ws + WS_WODV) + (size_t)(n0 - 2304) * D;
            tr_item(p.odd_w_in, 3072, D, kb * 64, n0, drow, scr, lane); continue; }
        r -= I_OD;
        {
            const int kb = r & 15, g = (r >> 4) & 3, part = r >> 6;
            for (int i = lane; i < 64; i += 64) { scr[i] = __builtin_amdgcn_cosf((float)i * (1.f / 64.f)); scr[64 + i] = __builtin_amdgcn_sinf((float)i * (1.f / 64.f)); }
            asm volatile("s_waitcnt lgkmcnt(0)" ::: "memory");
            const int k = kb * 64 + lane; const float* wr = p.even_w_in + (size_t)k * 2592 + g * 64;
            float w[64];
#pragma unroll
            for (int c4 = 0; c4 < 16; ++c4) { const f32x4 v = *(const f32x4*)(wr + 4 * c4); w[4 * c4] = v[0]; w[4 * c4 + 1] = v[1]; w[4 * c4 + 2] = v[2]; w[4 * c4 + 3] = v[3]; }
            const bool isq = part >= 2; const int k2b = (part & 1) * 32; const LAS float* tw = scr + (isq ? 64 : 0);
            bf16_t* wpq = (bf16_t*)(F.ws + WS_WPQ);
            for (int kk = 0; kk < 32; ++kk) { const int k2 = k2b + kk; float s = 0.f;
#pragma unroll
                for (int c = 0; c < 64; ++c) s += w[c] * tw[(c * k2) & 63];
                if (isq) s = -s;
                wpq[(size_t)((isq ? 256 : 0) + g * 64 + k2) * D + k] = (bf16_t)f2bf(s); }
            asm volatile("s_waitcnt lgkmcnt(0)" ::: "memory");
        }
    }
}
__device__ __forceinline__ void prep_phase(PRef p, Frame& F) {
    mod_table(p, F);
    for (int it = F.vcu; it < 576; it += F.G) mod_item(p, F, it);
    prep_items(p, F, 0, F.vcu * 8 + F.wave, F.G * 8);
    const int gt = F.vcu * 512 + F.tid, NGT = F.G * 512;
    { u32x4* z = (u32x4*)((bf16_t*)(F.ws + WS_WEV) + (size_t)1568 * D); for (int i = gt; i < 224 * D / 8; i += NGT) z[i] = (u32x4){0u, 0u, 0u, 0u}; }
    for (int i = gt; i < 256 * 512; i += NGT) { const int k1 = i >> 9, cc = i & 511, t = cc & 255; const float fr = (float)((k1 * t) & 255) * (1.f / 256.f);
        F_CSC[i] = (bf16_t)f2bf(cc < 256 ? __builtin_amdgcn_cosf(fr) : __builtin_amdgcn_sinf(fr)); }
    for (int i = gt; i < TL * 32; i += NGT) { const int t = i >> 5, j = i & 31; const float pos = (float)(j < 16 ? (t >> 6) : (t & 63));
        const float inv = __builtin_amdgcn_exp2f(-(float)(j & 15) * (13.287712379549449f / 16.f)); const float ang = pos * inv;
        float rev = ang * 0.15915494309189535f; rev -= floorf(rev);
        F_ROPE[t * 64 + j] = __builtin_amdgcn_cosf(rev); F_ROPE[t * 64 + 32 + j] = __builtin_amdgcn_sinf(rev); }
}
__device__ __forceinline__ void cs_gen(Frame& F) {
    const int gt = F.vcu * 512 + F.tid, NGT = F.G * 512;
    for (int i = gt; i < TL * 512; i += NGT) { const int k1 = i >> 9, c8 = (i & 511) * 8; const bool sn = c8 >= TL; const int t0 = c8 & (TL - 1);
        float v[8];
#pragma unroll
        for (int e = 0; e < 8; ++e) { const float fr = (float)((k1 * (t0 + e)) & (TL - 1)) * (1.f / 2048.f); v[e] = sn ? __builtin_amdgcn_sinf(fr) : __builtin_amdgcn_cosf(fr); }
        u32x4 o; o.x = pk2(v[0], v[1]); o.y = pk2(v[2], v[3]); o.z = pk2(v[4], v[5]); o.w = pk2(v[6], v[7]);
        *(u32x4*)(F_CS + (size_t)k1 * 4096 + c8) = o; }
}
__device__ __forceinline__ void prenorm_phase(Frame& F, const float* src_lat, const float* src_ctx, int nrows, const float* gain, const float* modl, int slot_sh, const float* pgate = nullptr, float pcoef = 0.f, int r0 = 0, size_t a_off = WS_A, size_t part_off = WS_PART) {
    const int gw = F.vcu * 8 + F.wave, NGW = F.G * 8, lane = F.lane;
    for (int r = r0 + gw; r < nrows; r += NGW) {
        const bool lat = r < NLAT; const float* xr = lat ? src_lat + (size_t)r * D : src_ctx + (size_t)(r - NLAT) * D; const int cond = lat ? (r >> 11) : 8;
        const float* sh = modl + (size_t)cond * (NMOD * D) + slot_sh * D; const float* sc = sh + D;
        f32x4 v[4]; float s = 0.f;
#pragma unroll
        for (int j = 0; j < 4; ++j) { v[j] = *(const f32x4*)(xr + 4 * lane + 256 * j);
            if (pgate && !lat) {
                const bf16_t* pp = (const bf16_t*)(F.ws + part_off) + (size_t)(r - NLAT) * D + 4 * lane + 256 * j; f32x4 a = (f32x4){0.f, 0.f, 0.f, 0.f};
#pragma unroll
                for (int q = 0; q < 8; ++q) { const u32x2 w = *(const u32x2*)(pp + (size_t)q * NCTX * D); a += (f32x4){bf2f(w.x & 0xffffu), bf2f(w.x >> 16), bf2f(w.y & 0xffffu), bf2f(w.y >> 16)}; }
                v[j] += a * (*(const f32x4*)(pgate + 4 * lane + 256 * j) * pcoef);
                *(f32x4*)(F_HC + (size_t)(r - NLAT) * D + 4 * lane + 256 * j) = v[j]; }
            s += (v[j][0] * v[j][0] + v[j][1] * v[j][1]) + (v[j][2] * v[j][2] + v[j][3] * v[j][3]); }
        const float rstd = rsqrtf(wave_sum(s) * (1.f / D) + EPS);
        bf16_t* orow = (bf16_t*)(F.ws + a_off) + (size_t)r * D;
#pragma unroll
        for (int j = 0; j < 4; ++j) { const int c0 = 4 * lane + 256 * j; const f32x4 g = *(const f32x4*)(gain + c0), a = *(const f32x4*)(sc + c0), b = *(const f32x4*)(sh + c0);
            const f32x4 y = (v[j] * rstd) * g * (a + 1.0f) + b; u32x2 o; o.x = pk2(y[0], y[1]); o.y = pk2(y[2], y[3]); *(u32x2*)(orow + c0) = o; }
    }
}
__device__ __forceinline__ void final_norm_phase(PRef p, Frame& F) {
    const int gw = F.vcu * 8 + F.wave, NGW = F.G * 8, lane = F.lane;
    for (int r = gw; r < NLAT; r += NGW) {
        float* xr = p.out + (size_t)r * D; f32x4 v[4]; float s = 0.f;
#pragma unroll
        for (int j = 0; j < 4; ++j) { v[j] = *(const f32x4*)(xr + 4 * lane + 256 * j); s += (v[j][0] * v[j][0] + v[j][1] * v[j][1]) + (v[j][2] * v[j][2] + v[j][3] * v[j][3]); }
        const float rstd = rsqrtf(wave_sum(s) * (1.f / D) + EPS);
#pragma unroll
        for (int j = 0; j < 4; ++j) { const int c0 = 4 * lane + 256 * j; const f32x4 g = *(const f32x4*)(p.final_norm + c0); *(f32x4*)(xr + c0) = (v[j] * rstd) * g; }
    }
}

__device__ __forceinline__ void gla_stream(PRef p, Frame& F, int sid) {
    const int tid = F.tid, lane = F.lane, w = F.wave, fr = lane & 15, fq = lane >> 4;
    const int dir = sid & 1, bh = sid >> 1, b = bh / 6, h = bh % 6;
    constexpr int SET = 4 * 64 * 72 + 128 * 72 - 64 * 72;
    LAS bf16_t* stg = (LAS bf16_t*)F.lds;
    LAS bf16_t* att = stg + 2 * SET;
    LAS bf16_t* Sb = att + 64 * 72;
    LAS float* ebl = (LAS float*)(Sb + 128 * 72);
    LAS float* gwl = ebl + 128;
    LAS float* gbl = gwl + 16 * 64;
    const bf16_t* z = F_ACT; const bf16_t* VT = F_VT + (size_t)(b * 768 + h * 128) * KVT; bf16_t* obuf = dir ? F_OB : F_OF;
    for (int i = tid; i < 16 * 64; i += 512) gwl[i] = p.gla_gate_w[(size_t)(dir * 16 + (i >> 6)) * 384 + h * 64 + (i & 63)];
    if (tid < 64) gbl[tid] = p.gla_gate_b[dir * 384 + h * 64 + tid];
    f32x4 st[4];
#pragma unroll
    for (int nb = 0; nb < 4; ++nb) st[nb] = (f32x4){0.f, 0.f, 0.f, 0.f};
    for (int i = tid; i < 128 * 72 / 2; i += 512) ((LAS unsigned*)Sb)[i] = 0u;
    u32x4 qraw, kraw, g0, g1, vraw[2];
#define GLA_ROW0(step_) (((step_) < 4) ? (size_t)NLAT + b * TC + 64 * (dir ? 3 - (step_) : (step_)) : (size_t)b * TL + 64 * (dir ? 35 - (step_) : (step_) - 4))
#define GLA_KV0(step_) (((step_) < 4) ? TL + 64 * (dir ? 3 - (step_) : (step_)) : 64 * (dir ? 35 - (step_) : (step_) - 4))
#define GLA_LOAD(step_) do { const bf16_t* zr_ = z + (GLA_ROW0(step_) + tk) * EV_LD; \
        qraw = *(const u32x4*)(zr_ + h * 64 + 8 * w); kraw = *(const u32x4*)(zr_ + 384 + h * 64 + 8 * w); \
        g0 = *(const u32x4*)(zr_ + 1536 + dir * 16); g1 = *(const u32x4*)(zr_ + 1536 + dir * 16 + 8); \
        const int kv0_ = GLA_KV0(step_); _Pragma("unroll") for (int i_ = 0; i_ < 2; ++i_) { const int id_ = tid + 512 * i_; vraw[i_] = *(const u32x4*)(VT + (size_t)(id_ >> 3) * KVT + kv0_ + (id_ & 7) * 8); } } while (0)
    const int tk = dir ? 63 - lane : lane;
    GLA_LOAD(0);
    __syncthreads();
    for (int step = 0; step < 36; ++step) {
        const size_t row0 = GLA_ROW0(step);
        LAS bf16_t* qd = stg + (step & 1) * SET; LAS bf16_t* kd = qd + 64 * 72; LAS bf16_t* kdT = kd + 64 * 72; LAS bf16_t* Vt = kdT + 64 * 72; LAS float* eb = ebl + (step & 1) * 64;
        float zg[16], q8[8], k8[8];
#pragma unroll
        for (int qq = 0; qq < 4; ++qq) { zg[2 * qq] = bf2f(g0[qq] & 0xffffu); zg[2 * qq + 1] = bf2f(g0[qq] >> 16); zg[8 + 2 * qq] = bf2f(g1[qq] & 0xffffu); zg[8 + 2 * qq + 1] = bf2f(g1[qq] >> 16);
            q8[2 * qq] = bf2f(qraw[qq] & 0xffffu); q8[2 * qq + 1] = bf2f(qraw[qq] >> 16); k8[2 * qq] = bf2f(kraw[qq] & 0xffffu); k8[2 * qq + 1] = bf2f(kraw[qq] >> 16); }
#pragma unroll
        for (int i = 0; i < 2; ++i) { const int id = tid + 512 * i; *(LAS u32x4*)(Vt + (id >> 3) * 72 + (id & 7) * 8) = vraw[i]; }
        if (step + 1 < 36) GLA_LOAD(step + 1);
        float lg[8];
        { f32x4 x0 = *(const LAS f32x4*)(gbl + 8 * w), x1 = *(const LAS f32x4*)(gbl + 8 * w + 4);
#pragma unroll
          for (int r = 0; r < 16; ++r) { const f32x4 w0 = *(const LAS f32x4*)(gwl + r * 64 + 8 * w), w1 = *(const LAS f32x4*)(gwl + r * 64 + 8 * w + 4); x0 += w0 * zg[r]; x1 += w1 * zg[r]; }
#pragma unroll
          for (int j = 0; j < 4; ++j) { lg[j] = (fminf(x0[j], 0.f) - __logf(1.f + __expf(-fabsf(x0[j])))) * (1.f / 16.f); lg[4 + j] = (fminf(x1[j], 0.f) - __logf(1.f + __expf(-fabsf(x1[j])))) * (1.f / 16.f); } }
#pragma unroll
        for (int j = 0; j < 8; ++j) { float x = lg[j];
            x += DPPF(x, 0x111, 0xf, 0xf); x += DPPF(x, 0x112, 0xf, 0xf); x += DPPF(x, 0x114, 0xf, 0xf); x += DPPF(x, 0x118, 0xf, 0xf);
            x += DPPF(x, 0x142, 0xa, 0xf); x += DPPF(x, 0x143, 0xc, 0xf); lg[j] = x; }
        float qo[8], ko[8], kc[8];
#pragma unroll
        for (int j = 0; j < 8; j += 2) {
            const float bl0 = __int_as_float(__builtin_amdgcn_readlane(__float_as_int(lg[j]), 63)), bl1 = __int_as_float(__builtin_amdgcn_readlane(__float_as_int(lg[j + 1]), 63));
            const f32x2_t qq = (f32x2_t){q8[j], q8[j + 1]} * 0.125f, kk = (f32x2_t){k8[j], k8[j + 1]};
            const f32x2_t e1 = (f32x2_t){__expf(lg[j]), __expf(lg[j + 1])}, e2 = (f32x2_t){__expf(-lg[j]), __expf(-lg[j + 1])}, e3 = (f32x2_t){__expf(bl0 - lg[j]), __expf(bl1 - lg[j + 1])};
            const f32x2_t a_ = qq * e1, b_ = kk * e2, c_ = kk * e3;
            qo[j] = a_.x; qo[j + 1] = a_.y; ko[j] = b_.x; ko[j + 1] = b_.y; kc[j] = c_.x; kc[j + 1] = c_.y;
            if (lane == 0) { eb[8 * w + j] = __expf(bl0); eb[8 * w + j + 1] = __expf(bl1); } }
        { u32x4 o; o.x = pk2(qo[0], qo[1]); o.y = pk2(qo[2], qo[3]); o.z = pk2(qo[4], qo[5]); o.w = pk2(qo[6], qo[7]); *(LAS u32x4*)(qd + tk * 72 + 8 * w) = o;
          o.x = pk2(ko[0], ko[1]); o.y = pk2(ko[2], ko[3]); o.z = pk2(ko[4], ko[5]); o.w = pk2(ko[6], ko[7]); *(LAS u32x4*)(kd + tk * 72 + 8 * w) = o; }
#pragma unroll
        for (int j = 0; j < 8; ++j) kdT[(8 * w + j) * 72 + tk] = (bf16_t)f2bf(kc[j]);
        __syncthreads();
        {
            const int ib = w >> 1, jb0 = 2 * (w & 1);
            const bf16x8 a0 = *(const LAS bf16x8*)(qd + (16 * ib + fr) * 72 + fq * 8), a1 = *(const LAS bf16x8*)(qd + (16 * ib + fr) * 72 + 32 + fq * 8);
#pragma unroll
            for (int jj = 0; jj < 2; ++jj) { const int jb = jb0 + jj;
                const bf16x8 b0 = *(const LAS bf16x8*)(kd + (16 * jb + fr) * 72 + fq * 8), b1 = *(const LAS bf16x8*)(kd + (16 * jb + fr) * 72 + 32 + fq * 8);
                f32x4 cc = (f32x4){0.f, 0.f, 0.f, 0.f}; cc = MFMA16(a0, b0, cc); cc = MFMA16(a1, b1, cc);
#pragma unroll
                for (int e = 0; e < 4; ++e) { const int i = 16 * ib + 4 * fq + e, j = 16 * jb + fr; const bool keep = dir ? (j >= i) : (j <= i); att[i * 72 + j] = (bf16_t)f2bf(keep ? cc[e] : 0.f); } }
        }
        __syncthreads();
        {
            const bf16x8 sA0 = *(const LAS bf16x8*)(Sb + (16 * w + fr) * 72 + fq * 8), sA1 = *(const LAS bf16x8*)(Sb + (16 * w + fr) * 72 + 32 + fq * 8);
            const bf16x8 vA0 = *(const LAS bf16x8*)(Vt + (16 * w + fr) * 72 + fq * 8), vA1 = *(const LAS bf16x8*)(Vt + (16 * w + fr) * 72 + 32 + fq * 8);
#pragma unroll
            for (int ib = 0; ib < 4; ++ib) {
                const bf16x8 q0 = *(const LAS bf16x8*)(qd + (16 * ib + fr) * 72 + fq * 8), q1 = *(const LAS bf16x8*)(qd + (16 * ib + fr) * 72 + 32 + fq * 8);
                const bf16x8 t0 = *(const LAS bf16x8*)(att + (16 * ib + fr) * 72 + fq * 8), t1 = *(const LAS bf16x8*)(att + (16 * ib + fr) * 72 + 32 + fq * 8);
                f32x4 cc = (f32x4){0.f, 0.f, 0.f, 0.f}; cc = MFMA16(sA0, q0, cc); cc = MFMA16(sA1, q1, cc); cc = MFMA16(vA0, t0, cc); cc = MFMA16(vA1, t1, cc);
                u32x2 o; o.x = pk2(cc[0], cc[1]); o.y = pk2(cc[2], cc[3]);
                *(u32x2*)(obuf + (row0 + 16 * ib + fr) * 768 + h * 128 + 16 * w + 4 * fq) = o;
            }
#pragma unroll
            for (int nb = 0; nb < 4; ++nb) {
                const float dcy = eb[16 * nb + fr]; st[nb] = st[nb] * dcy;
                const bf16x8 k0 = *(const LAS bf16x8*)(kdT + (16 * nb + fr) * 72 + fq * 8), k1 = *(const LAS bf16x8*)(kdT + (16 * nb + fr) * 72 + 32 + fq * 8);
                st[nb] = MFMA16(vA0, k0, st[nb]); st[nb] = MFMA16(vA1, k1, st[nb]);
#pragma unroll
                for (int e = 0; e < 4; ++e) Sb[(16 * w + 4 * fq + e) * 72 + 16 * nb + fr] = (bf16_t)f2bf(st[nb][e]);
            }
        }
    }
#undef GLA_LOAD
#undef GLA_ROW0
#undef GLA_KV0
    __syncthreads();
}
__device__ __forceinline__ void combine_phase(PRef p, Frame& F) {
    const int gw = F.vcu * 8 + F.wave, NGW = F.G * 8, lane = F.lane;
    for (int r = gw; r < NROW; r += NGW) {
#pragma unroll
        for (int it = 0; it < 3; ++it) {
            const int idx = it * 256 + lane * 4;
            const u32x2 a = *(const u32x2*)(F_OF + (size_t)r * 768 + idx), bq = *(const u32x2*)(F_OB + (size_t)r * 768 + idx), zr = *(const u32x2*)(F_ACT + (size_t)r * EV_LD + 768 + idx);
            float v[4] = {bf2f(a.x & 0xffffu) + bf2f(bq.x & 0xffffu), bf2f(a.x >> 16) + bf2f(bq.x >> 16), bf2f(a.y & 0xffffu) + bf2f(bq.y & 0xffffu), bf2f(a.y >> 16) + bf2f(bq.y >> 16)};
            float ss = (v[0] * v[0] + v[1] * v[1]) + (v[2] * v[2] + v[3] * v[3]);
#pragma unroll
            for (int o = 1; o < 32; o <<= 1) ss += __shfl_xor(ss, o);
            const float rstd = rsqrtf(ss * (1.f / 128.f) + EPS);
            const f32x4 g = *(const f32x4*)(p.gla_norm + (idx & 127));
            const float z0 = bf2f(zr.x & 0xffffu), z1 = bf2f(zr.x >> 16), z2 = bf2f(zr.y & 0xffffu), z3 = bf2f(zr.y >> 16);
            u32x2 o; o.x = pk2(v[0] * rstd * g[0] * silu_f(z0), v[1] * rstd * g[1] * silu_f(z1)); o.y = pk2(v[2] * rstd * g[2] * silu_f(z2), v[3] * rstd * g[3] * silu_f(z3));
            *(u32x2*)(F_ABUF + (size_t)r * D + 256 + idx) = o;
        }
    }
}

__device__ __forceinline__ void conv_part(PRef p, Frame& F) {
    const int gt = F.vcu * 512 + F.tid, NGT = F.G * 512; const bf16_t* z = F_ACT;
    for (int i = gt; i < NLAT * 32; i += NGT) {
        const int row = i >> 5, c8 = (i & 31) * 8, t = row & (TL - 1);
        const bf16_t* zr = z + (size_t)row * OD_LD;
        const u32x4 zb = *(const u32x4*)(zr + c8), c1 = *(const u32x4*)(zr + 256 + c8), x1 = *(const u32x4*)(zr + 512 + c8);
        u32x4 c0 = (u32x4){0u, 0u, 0u, 0u}, x0 = c0, c2 = c0, x2 = c0;
        if (t > 0) { c0 = *(const u32x4*)(zr - OD_LD + 256 + c8); x0 = *(const u32x4*)(zr - OD_LD + 512 + c8); }
        if (t < TL - 1) { c2 = *(const u32x4*)(zr + OD_LD + 256 + c8); x2 = *(const u32x4*)(zr + OD_LD + 512 + c8); }
        float o[8];
#pragma unroll
        for (int q = 0; q < 4; ++q)
#pragma unroll
            for (int hh = 0; hh < 2; ++hh) {
                const int c = c8 + 2 * q + hh;
                const float u0 = (hh ? bf2f(c0[q] >> 16) : bf2f(c0[q] & 0xffffu)) * (hh ? bf2f(x0[q] >> 16) : bf2f(x0[q] & 0xffffu));
                const float u1 = (hh ? bf2f(c1[q] >> 16) : bf2f(c1[q] & 0xffffu)) * (hh ? bf2f(x1[q] >> 16) : bf2f(x1[q] & 0xffffu));
                const float u2 = (hh ? bf2f(c2[q] >> 16) : bf2f(c2[q] & 0xffffu)) * (hh ? bf2f(x2[q] >> 16) : bf2f(x2[q] & 0xffffu));
                const float zbv = hh ? bf2f(zb[q] >> 16) : bf2f(zb[q] & 0xffffu);
                o[2 * q + hh] = zbv * (u0 * p.conv_w[c] + u1 * p.conv_w[256 + c] + u2 * p.conv_w[512 + c] + p.conv_b[c]);
            }
        u32x4 w; w.x = pk2(o[0], o[1]); w.y = pk2(o[2], o[3]); w.z = pk2(o[4], o[5]); w.w = pk2(o[6], o[7]);
        *(u32x4*)(F_ABUF + (size_t)row * D + c8) = w;
    }
}
__device__ __forceinline__ void attn_unit(PRef p, Frame& F, int unit, float lam) {
    const int tid = F.tid, lane = F.lane, w = F.wave, r32 = lane & 31, hi = lane >> 5, s = w >> 2, qw = w & 3;
    const int bh = unit >> 4, qh = unit & 15, b = bh / 6, h = bh % 6, q0 = qh * 128;
    constexpr int KROW = 272, VROW = 136, KBUF = 64 * KROW, VBUF = 128 * VROW, VOFF = 2 * KBUF;
    const bf16_t* z = F_ACT; const bf16_t* VT = F_VT + (size_t)(b * 768 + h * 128) * KVT;
    const size_t qrow = (size_t)b * TL + q0 + 32 * qw + r32;
    bf16x8 qr[4];
#pragma unroll
    for (int d0 = 0; d0 < 4; ++d0) qr[d0] = *(const bf16x8*)(z + qrow * OD_LD + 768 + h * 128 + s * 64 + d0 * 16 + hi * 8);
    int kr[2], kc[2], vr[2], vc[2];
#pragma unroll
    for (int i = 0; i < 2; ++i) { const int id = tid + 512 * i; kr[i] = id >> 4; kc[i] = id & 15; vr[i] = id >> 3; vc[i] = id & 7; }
    u32x4 kreg[2], vreg[2];
    const char* kbase_lat = (const char*)(z + ((size_t)b * TL) * OD_LD + 1536 + h * 128); const char* kbase_ctx = (const char*)(z + ((size_t)NLAT + (size_t)b * TC) * OD_LD + 1536 + h * 128);
    unsigned koffb[2], voffb[2];
#pragma unroll
    for (int i = 0; i < 2; ++i) { koffb[i] = (unsigned)(kr[i] * OD_LD + kc[i] * 8) * 2u; voffb[i] = (unsigned)(vr[i] * KVT + vc[i] * 8) * 2u; }
#define ATT_LOADK(t) do { const char* kb_ = (t) < 32 ? kbase_lat + (size_t)(t) * (64 * OD_LD * 2) : kbase_ctx + (size_t)((t) - 32) * (64 * OD_LD * 2); \
        _Pragma("unroll") for (int i = 0; i < 2; ++i) kreg[i] = *(const u32x4*)(kb_ + koffb[i]); } while (0)
#define ATT_LOADV(t) do { const char* vb_ = (const char*)VT + (size_t)(t) * 128; _Pragma("unroll") for (int i = 0; i < 2; ++i) vreg[i] = *(const u32x4*)(vb_ + voffb[i]); } while (0)
#define ATT_STOREK(buf) do { _Pragma("unroll") for (int i = 0; i < 2; ++i) *(LAS u32x4*)(F.lds + (buf) * KBUF + kr[i] * KROW + kc[i] * 16) = kreg[i]; } while (0)
#define ATT_STOREV(buf) do { _Pragma("unroll") for (int i = 0; i < 2; ++i) { \
        *(LAS u32x2*)(F.lds + VOFF + (buf) * VBUF + vr[i] * VROW + vc[i] * 16) = (u32x2){vreg[i].x, vreg[i].y}; \
        *(LAS u32x2*)(F.lds + VOFF + (buf) * VBUF + vr[i] * VROW + vc[i] * 16 + 8) = (u32x2){vreg[i].z, vreg[i].w}; } } while (0)
#define SB() do {} while (0)
#define Z16 ((f32x16){0.f, 0.f, 0.f, 0.f, 0.f, 0.f, 0.f, 0.f, 0.f, 0.f, 0.f, 0.f, 0.f, 0.f, 0.f, 0.f})
#define ATT_QK(kb_) do { const LAS unsigned char* Kb = F.lds + (kb_) * KBUF + r32 * KROW + (s * 64 + hi * 8) * 2; \
        _Pragma("unroll") for (int d0 = 0; d0 < 4; ++d0) { \
            const bf16x8 a0 = *(const LAS bf16x8*)(Kb + d0 * 32), a1 = *(const LAS bf16x8*)(Kb + 32 * KROW + d0 * 32); \
            if (d0 == 0) { p0 = MFMA32(a0, qr[0], Z16); p1 = MFMA32(a1, qr[0], Z16); } else { p0 = MFMA32(a0, qr[d0], p0); p1 = MFMA32(a1, qr[d0], p1); } } } while (0)
#define ATT_PVG(kb, ks) do { _Pragma("unroll") for (int nb = 0; nb < 4; ++nb) { \
            const LAS unsigned char* vp = Vb + nb * 32 * VROW + ((kb) * 32 + (ks) * 16) * 2; \
            const s16x4 lo = *(const LAS s16x4*)(vp), hh = *(const LAS s16x4*)(vp + 16); \
            const bf16x8 af = (bf16x8){lo[0], lo[1], lo[2], lo[3], hh[0], hh[1], hh[2], hh[3]}; \
            o[nb] = MFMA32(af, __builtin_bit_cast(bf16x8, pf[kb][ks]), o[nb]); } } while (0)
#define ATT_MAX8(P, B) fmaxf(fmaxf(fmaxf(fmaxf(fmaxf(fmaxf(fmaxf(P[B], P[B + 1]), P[B + 2]), P[B + 3]), P[B + 4]), P[B + 5]), P[B + 6]), P[B + 7])
#define ATT_EXP8(P, B, DST) do { _Pragma("unroll") for (int r = 0; r < 8; r += 2) {   \
            const f32x2_t d_ = (f32x2_t){P[B + r], P[B + r + 1]} - (f32x2_t){m_run, m_run}; \
            const f32x2_t e_ = (f32x2_t){__builtin_amdgcn_exp2f(d_.x), __builtin_amdgcn_exp2f(d_.y)}; rs2 += e_; P[B + r] = e_.x; P[B + r + 1] = e_.y; } \
        DST = (u32x4){cvt_pk_bf16(P[B], P[B + 1]), cvt_pk_bf16(P[B + 2], P[B + 3]), cvt_pk_bf16(P[B + 4], P[B + 5]), cvt_pk_bf16(P[B + 6], P[B + 7])}; } while (0)
    f32x16 o[4];
#pragma unroll
    for (int nb = 0; nb < 4; ++nb)
#pragma unroll
        for (int r = 0; r < 16; ++r) o[nb][r] = 0.f;
    float m_run = 0.f, l_run = 0.f;
    u32x4 pf[2][2]; f32x16 p0, p1;
    constexpr int NT = KVT / 64;
    ATT_LOADK(0); ATT_LOADV(0); ATT_STOREK(0); ATT_STOREV(0); ATT_LOADK(1); ATT_STOREK(1);
    __syncthreads();
    {
        ATT_QK(0);
        float mx = fmaxf(ATT_MAX8(p0, 0), ATT_MAX8(p0, 8)); mx = fmaxf(mx, fmaxf(ATT_MAX8(p1, 0), ATT_MAX8(p1, 8)));
        mx = fmaxf(mx, __shfl_xor(mx, 32)); m_run = mx;
        f32x2_t rs2 = (f32x2_t){0.f, 0.f};
        ATT_EXP8(p0, 0, pf[0][0]); ATT_EXP8(p0, 8, pf[0][1]); ATT_EXP8(p1, 0, pf[1][0]); ATT_EXP8(p1, 8, pf[1][1]);
        l_run = rs2.x + rs2.y;
    }
    __syncthreads();
    for (int t = 0; t < NT; ++t) {
        const bool more = t + 1 < NT;
        if (t + 2 < NT) ATT_LOADK(t + 2);
        if (more) ATT_LOADV(t + 1);
        const LAS unsigned char* Vb = F.lds + VOFF + (t & 1) * VBUF + r32 * VROW + hi * 8;
        if (more) {
            ATT_QK((t + 1) & 1);
            SB();
            ATT_PVG(0, 0);
            float mx = fmaxf(ATT_MAX8(p0, 0), ATT_MAX8(p0, 8));
            SB();
            ATT_PVG(0, 1);
            mx = fmaxf(mx, fmaxf(ATT_MAX8(p1, 0), ATT_MAX8(p1, 8)));
            mx = fmaxf(mx, __shfl_xor(mx, 32)) - m_run;
            const bool need = __any(mx > 8.0f);
            const float dl = need ? fmaxf(mx, 0.f) : 0.f; m_run += dl;
            const float alpha = __builtin_amdgcn_exp2f(-dl); l_run *= alpha;
            f32x2_t rs2 = (f32x2_t){0.f, 0.f};
            SB();
            ATT_PVG(1, 0);
            u32x4 n00, n01, n10, n11;
            ATT_EXP8(p0, 0, n00); ATT_EXP8(p0, 8, n01);
            SB();
            ATT_PVG(1, 1);
            ATT_EXP8(p1, 0, n10);
            SB();
            ATT_EXP8(p1, 8, n11);
            l_run += rs2.x + rs2.y;
            pf[0][0] = n00; pf[0][1] = n01; pf[1][0] = n10; pf[1][1] = n11;
            if (need) {
#pragma unroll
                for (int nb = 0; nb < 4; ++nb)
#pragma unroll
                    for (int r = 0; r < 16; ++r) o[nb][r] *= alpha;
            }
        } else {
            ATT_PVG(0, 0); ATT_PVG(0, 1); ATT_PVG(1, 0); ATT_PVG(1, 1);
        }
        if (t + 2 < NT) ATT_STOREK(t & 1);
        if (more) ATT_STOREV((t + 1) & 1);
        __syncthreads();
    }
#undef ATT_LOADK
#undef ATT_LOADV
#undef ATT_STOREK
#undef ATT_STOREV
#undef ATT_QK
#undef ATT_PVG
#undef ATT_MAX8
#undef ATT_EXP8
#undef SB
#undef Z16
    l_run += __shfl_xor(l_run, 32);
    const float inv = 1.0f / l_run;
    LAS float* ex = (LAS float*)F.lds;
    if (s == 1) {
#pragma unroll
        for (int nb = 0; nb < 4; ++nb)
#pragma unroll
            for (int r = 0; r < 16; ++r) ex[(qw * 64 + nb * 16 + r) * 64 + lane] = o[nb][r] * inv;
    }
    __syncthreads();
    if (s == 0) {
        float ss = 0.f;
#pragma unroll
        for (int nb = 0; nb < 4; ++nb)
#pragma unroll
            for (int r = 0; r < 16; ++r) { const float y = o[nb][r] * inv - lam * ex[(qw * 64 + nb * 16 + r) * 64 + lane]; o[nb][r] = y; ss += y * y; }
        ss += __shfl_xor(ss, 32);
        const float rstd = rsqrtf(ss * (1.f / 128.f) + EPS) * (1.0f - LAM_INIT);
        bf16_t* orow = F_ABUF + qrow * D + 256 + h * 128;
#pragma unroll
        for (int nb = 0; nb < 4; ++nb)
#pragma unroll
            for (int rq = 0; rq < 4; ++rq) {
                const int dv = 32 * nb + 8 * rq + 4 * hi; const f32x4 g = *(const f32x4*)(p.diff_norm + dv);
                u32x2 ov; ov.x = pk2(o[nb][4 * rq] * rstd * g[0], o[nb][4 * rq + 1] * rstd * g[1]); ov.y = pk2(o[nb][4 * rq + 2] * rstd * g[2], o[nb][4 * rq + 3] * rstd * g[3]);
                *(u32x2*)(orow + dv) = ov;
            }
    }
    __syncthreads();
}

#define XB_TMO      128
#define XB_XCNT(j)  (256  + 64 * (j))
#define XB_XSUB(j)  (1280 + 64 * (j))
#define XB_XGEN(j)  (2304 + 64 * (j))
#define XB_TOP      3328
#define XB_TOPGEN   3392
#define XCD_BAR_WORDS 3456
#define XB_SPIN_CAP (1u << 18)

__device__ __forceinline__ unsigned xb_ld(unsigned* p)              { return __hip_atomic_load(p, __ATOMIC_RELAXED, __HIP_MEMORY_SCOPE_AGENT); }
__device__ __forceinline__ unsigned xb_add(unsigned* p, unsigned v) { return __hip_atomic_fetch_add(p, v, __ATOMIC_RELAXED, __HIP_MEMORY_SCOPE_AGENT); }
__device__ __forceinline__ unsigned xb_xcc_id() { return (unsigned)__builtin_amdgcn_s_getreg((3 << 11) | 20) & 0xFu; }
#define XB_SPIN(cond, bar) do { unsigned _sp = 0; while (cond) { __builtin_amdgcn_s_sleep(1); \
    if ((++_sp & 255u) == 0u) { if (xb_ld(&(bar)[XB_TMO])) break; if (_sp > XB_SPIN_CAP) { atomicAdd(&(bar)[XB_TMO], 1u); break; } } } } while (0)

struct XcdBarrier {
    unsigned* bar; unsigned x;
    volatile LAS unsigned* st;
};

__device__ __forceinline__ XcdBarrier xcd_barrier_post(unsigned* bar, volatile LAS unsigned* st, const bool t0) {
    XcdBarrier b; b.bar = bar; b.x = xb_xcc_id(); b.st = st;
    if (t0) (void)xb_add(&bar[XB_XCNT(b.x)], 1u);
    return b;
}
__device__ __forceinline__ void xcd_barrier_complete(unsigned* bar, unsigned x, unsigned& nloc, unsigned& nx) {
    const unsigned G = gridDim.x * gridDim.y * gridDim.z;
    unsigned sum, cnt, mine, sp = 0u;
    for (;;) {
        sum = 0u; cnt = 0u; mine = 0u;
#pragma unroll
        for (unsigned j = 0; j < 16; ++j) { const unsigned c = xb_ld(&bar[XB_XCNT(j)]); sum += c; cnt += (c > 0u) ? 1u : 0u; mine = (j == x) ? c : mine; }
        if (sum == G) break;
        __builtin_amdgcn_s_sleep(1);
        if ((++sp & 255u) == 0u) { if (xb_ld(&bar[XB_TMO])) break; if (sp > XB_SPIN_CAP) { atomicAdd(&bar[XB_TMO], 1u); break; } }
    }
    nloc = mine > 0u ? mine : 1u; nx = cnt > 0u ? cnt : 1u;
}

__device__ __forceinline__ void xcd_barrier(const XcdBarrier& b, const bool t0) {
    asm volatile("s_waitcnt vmcnt(0)" ::: "memory");
    __syncthreads();
    if (t0) {
        unsigned* bar = b.bar;
        __builtin_amdgcn_s_waitcnt(0);
        unsigned nloc = b.st[0], nx = b.st[1];
        if (nloc == 0u) { xcd_barrier_complete(bar, b.x, nloc, nx); b.st[0] = nloc; b.st[1] = nx; }
        const unsigned old = xb_add(&bar[XB_XSUB(b.x)], 1u);
        const unsigned gen = old / nloc;
        if (old + 1u == (gen + 1u) * nloc) {
            __builtin_amdgcn_fence(__ATOMIC_RELEASE, "agent");
            asm volatile("s_waitcnt vmcnt(0)" ::: "memory");
            const unsigned og = xb_add(&bar[XB_TOP], 1u);
            const unsigned tg = og / nx;
            if (og + 1u == (tg + 1u) * nx) xb_add(&bar[XB_TOPGEN], 1u);
            else XB_SPIN(xb_ld(&bar[XB_TOPGEN]) == tg, bar);
            __builtin_amdgcn_fence(__ATOMIC_ACQUIRE, "agent");
            xb_add(&bar[XB_XGEN(b.x)], 1u);
            asm volatile("s_waitcnt vmcnt(0)" ::: "memory");
        } else {
            XB_SPIN(xb_ld(&bar[XB_XGEN(b.x)]) == gen, bar);
            __builtin_amdgcn_fence(__ATOMIC_ACQUIRE, "agent");
            asm volatile("s_waitcnt vmcnt(0)" ::: "memory");
        }
    }
    __syncthreads();
}


template <int ph>
__device__ __forceinline__ void run_phase(PRef p, Frame& F) {
        if (ph == 0) { prep_phase(p, F); }
        else if (ph == 23) { final_norm_phase(p, F); }
        else {
            const int l = (ph - 1) / 11, q = (ph - 1) % 11;
            const unsigned wl = (unsigned)(WS_W0 + (size_t)l * W_LAYER);
            const float* modl = F_MOD + (size_t)l * 9 * (NMOD * D);
            const bool l0 = (l == 0);
            if (q == 0 || q == 3 || q == 8) {
                const float* sl = (l0 && q == 0) ? p.x : p.out; const float* sc = (l0 && q == 0) ? p.ctx : F_HC;
                const float* gain = (q == 0 ? p.norm_ffn1 : q == 3 ? p.norm_mix : p.norm_ffn2) + l * D;
                const int nrows = (!l0 && q == 8) ? NLAT : NROW;
                if (l0 && q == 3) cs_gen(F);
                const bool hasp = !(l0 && q == 0) && !(!l0 && q == 8);
                const float* pg = hasp ? (q == 0 ? F_MOD + 8 * D : modl + (q == 3 ? 2 : 5) * D) + (size_t)8 * (NMOD * D) : nullptr;
                const float* scx = (l0 && q == 3) ? p.ctx : sc;
                const int r0 = ((q == 3) || (q == 8) || (!l0 && q == 0)) ? NLAT : 0;
                prenorm_phase(F, sl, scx, nrows, gain, modl, q == 0 ? 0 : q == 3 ? 3 : 6, pg, (q == 8) ? 1.0f : 0.5f, r0, (q == 8) ? WS_A2 : WS_A, (q == 8) ? WS_ACT : WS_PART);
            } else if (q == 1 || q == 9 || q == 4 || (q == 5 && l0)) {
                pg8::Sched S; S.nfull = 0; S.parts = 1; S.kpart = 0; S.kbase = 0; S.pbase = 0; S.G = F.G; S.vcu = F.vcu; S.coff = 0; S.tstep = 256u * D * 2u; S.ws = (const char*)F.ws;
                const pg8::Seg none{0u, 0u, 0u}; S.s0 = none; S.s1 = none; S.s2 = none;
                pg8::EpiT E; E.ws = F.ws; E.dst_off = (unsigned)WS_ACT; E.ldc = FF;
                int K = D, ld = D, njob = 1;
                if (q == 1 || q == 9) {
                    const int nM = (!l0 && q == 9) ? 64 : 72;
                    S.s0 = pg8::mkseg((unsigned)((q == 9) ? WS_A2 : WS_A), wl + (unsigned)(q == 1 ? W_F1I : W_F2I), nM, 22, 0, 0, pg8::T_SWIGLU);
                    S.nfull = ((nM * 22) / 256) * 256;
                } else if (q == 4 && l0) {
                    E.ldc = EV_LD;
                    S.s0 = pg8::mkseg((unsigned)WS_A, (unsigned)WS_WEV, 72, 7, 0, 0, pg8::T_ZEV);
                    S.s1 = pg8::mkseg((unsigned)WS_WEVV, (unsigned)WS_A, 3, 72, 0, 0, pg8::T_TRV);
                    S.s2 = pg8::mkseg((unsigned)WS_WPQ, (unsigned)WS_A, 2, 72, 0, 0, pg8::T_TRPQ);
                    S.nfull = 768;
                } else if (q == 4) {
                    E.ldc = OD_LD;
                    S.s0 = pg8::mkseg((unsigned)WS_A, (unsigned)WS_WOD, 64, 9, 0, 0, pg8::T_ZODD);
                    S.s1 = pg8::mkseg((unsigned)WS_A, (unsigned)WS_WOD, 8, 3, 64, 6, pg8::T_ZODD);
                    S.s2 = pg8::mkseg((unsigned)WS_WODV, (unsigned)WS_A, 3, 72, 0, 0, pg8::T_TRV);
                    S.nfull = 768;
                } else {
                    E.dst_off = (unsigned)WS_A; E.ldc = D; njob = 2; K = 4096; ld = 4096; S.tstep = 256u * 4096u * 2u;
                    S.s0 = pg8::mkseg((unsigned)WS_CS, (unsigned)WS_PQT, 8, 8, 0, 0, pg8::T_FOUR);
                }
#pragma unroll 1
                for (int j = 0; j < njob; ++j) {
                    if (j == 1) { K = 512; ld = 512; S.coff = 64; S.tstep = 256u * 512u * 2u; S.s0 = pg8::mkseg((unsigned)WS_CSC, (unsigned)WS_PQTC, 1, 8, 0, 0, pg8::T_FOURC); S.s1 = none; }
                    if constexpr (q == 1 || q == 9 || q == 4) pg8::gemm_phase<pg8::EpiT, true>(F.lds, F.tid, K, ld, S, E); else pg8::gemm_phase<pg8::EpiT>(F.lds, F.tid, K, ld, S, E);
                }
                if (l0 && q == 1 && F.vcu >= 96) prep_items(p, F, 1, (F.vcu - 96) * 8 + F.wave, (F.G - 96) * 8);
                if (l0 && q == 5 && (F.vcu < 136 || F.vcu >= 232)) { const int wk = F.vcu < 136 ? F.vcu : 136 + (F.vcu - 232); prep_items(p, F, 3, wk * 8 + F.wave, 160 * 8); prep_items(p, F, 2, wk * 8 + F.wave, 160 * 8); }
                if (q == 5) { for (int sid = F.vcu - 136; sid >= 0 && sid < 96; sid += F.G) gla_stream(p, F, sid); }
            } else if (q == 2 || q == 10 || q == 7) {
                const bool first = l0 && q == 2;
                const bool ctxp = !(!l0 && q != 2);
                const int K = (q == 7) ? D : FF;
                pg8::Sched S; S.nfull = 0; S.parts = 1; S.kpart = 0; S.kbase = 0; S.pbase = 0; S.G = F.G; S.vcu = F.vcu; S.coff = 0; S.tstep = 256u * (unsigned)K * 2u; S.ws = (const char*)F.ws;
                const pg8::Seg none{0u, 0u, 0u}; S.s1 = none; S.s2 = none;
                const unsigned Aoff = (unsigned)(q == 7 ? WS_A : WS_ACT), Boff = wl + (unsigned)(q == 2 ? W_F1O : q == 10 ? W_F2O : W_MO);
                S.s0 = pg8::mkseg(Aoff, Boff, 64, 4, 0, 0, 0);
                if constexpr (!l0 && (q == 7 || q == 10)) {
                    const pg8::EpiRN E{p.out, modl + (q == 7 ? 5 : 8) * D, p.out, p.final_norm, p.out, (bf16_t*)(F.ws + WS_A2), p.norm_ffn2 + l * D, modl + 6 * D,
                                       (float*)(F.ws + WS_XBUF) + (q == 7 ? 0 : NLAT * 4), (unsigned*)(F.ws + WS_XCNT) + (q == 7 ? 0 : 64 * 64), (q == 7) ? 1.0f : 0.5f, (q == 7) ? 1 : 0};
                    pg8::gemm_phase<pg8::EpiRN>(F.lds, F.tid, K, K, S, E);
                } else if constexpr (l0 && q == 7) {
                    const pg8::EpiRN E{p.out, modl + 5 * D, p.out, p.final_norm, p.out, (bf16_t*)(F.ws + WS_A2), p.norm_ffn2, modl + 6 * D,
                                       (float*)(F.ws + WS_XBUF) + NLAT * 4, (unsigned*)(F.ws + WS_XCNT) + 5 * 64 * 64, 1.0f, 1};
                    pg8::gemm_phase<pg8::EpiRN>(F.lds, F.tid, K, K, S, E);
                } else if constexpr (q == 2 || (l0 && q == 10)) {
                    constexpr int site = l0 ? (q == 2 ? 2 : 3) : 4;
                    const float* ngain = (q == 2) ? p.norm_mix + l * D : p.norm_ffn1 + D;
                    const float* nscsh = (q == 2) ? modl + 3 * D : F_MOD + (size_t)9 * (NMOD * D);
                    const pg8::EpiRN E{first ? p.x : p.out, modl + (q == 2 ? 2 : 8) * D, p.out, p.final_norm, p.out, (bf16_t*)(F.ws + WS_A), ngain, nscsh,
                                       (float*)(F.ws + WS_XBUF) + (site & 1) * NLAT * 4, (unsigned*)(F.ws + WS_XCNT) + site * 64 * 64, 0.5f, 1};
                    pg8::gemm_phase<pg8::EpiRN>(F.lds, F.tid, K, K, S, E);
                } else {
                pg8::EpiR E; E.in_lat = first ? p.x : p.out; E.in_ctx = first ? p.ctx : F_HC; E.out_lat = p.out; E.out_ctx = F_HC;
                E.gate = modl + (q == 2 ? 2 : q == 7 ? 5 : 8) * D; E.coef = (q == 7) ? 1.0f : 0.5f;
                pg8::gemm_phase<pg8::EpiR>(F.lds, F.tid, K, K, S, E);
                }
                if (ctxp) {
                    const pg8::EpiP EP{(bf16_t*)(F.ws + ((l0 && q == 7) ? WS_ACT : WS_PART))};
                    S.s0 = pg8::mkseg(Aoff, Boff, 8, 4, 64, 0, 0);
                    const bool j0 = F.vcu < 192;
                    if (q == 7) { S.parts = 8; S.kpart = 128; }
                    else { S.parts = j0 ? 6 : 2; S.kpart = j0 ? 384 : 256; S.kbase = j0 ? 0 : 2304; S.pbase = j0 ? 0 : 6; S.coff = j0 ? 0 : 192; }
                    pg8::gemm_phase<pg8::EpiP>(F.lds, F.tid, S.kpart, K, S, EP);
                }
            } else if (q == 5) {
                float a1 = p.lq1[F.lane] * p.lk1[F.lane], a2 = p.lq2[F.lane] * p.lk2[F.lane];
                a1 = wave_sum(a1); a2 = wave_sum(a2);
                const float lam = __expf(a1) - __expf(a2) + LAM_INIT;
                conv_part(p, F);
                for (int u = F.vcu; u < 768; u += F.G) attn_unit(p, F, u, lam);
            } else if (q == 6) {
                if (l0) combine_phase(p, F);
            }
        }
}

__global__ void __launch_bounds__(512, 2) fwd_kernel(Params p_arg) {
    extern __shared__ __attribute__((aligned(16))) unsigned char lds_raw[];
    cg::grid_group grid = cg::this_grid();
    volatile LAS unsigned* st_ = (volatile LAS unsigned*)((LAS unsigned char*)lds_raw + 131072);
    const int wave_s = __builtin_amdgcn_readfirstlane(threadIdx.x >> 6);
    if (threadIdx.x < 4) st_[threadIdx.x] = 0u;
    __syncthreads();
    if (p_arg.ph_lo < 0) grid.sync();
    XcdBarrier bar = xcd_barrier_post((unsigned*)(p_arg.ws + WS_BAR), st_, (wave_s == 0) && (__builtin_amdgcn_mbcnt_hi(~0u, __builtin_amdgcn_mbcnt_lo(~0u, 0u)) == 0));
#define RUN_PHASE(k) { \
        KParams* kp_ = (KParams*)__builtin_amdgcn_kernarg_segment_ptr(); asm volatile("" : "+s"(kp_)); PRef p = *kp_; \
        Frame F; F.lds = (LAS unsigned char*)lds_raw; \
        int w_ = wave_s; asm volatile("" : "+s"(w_)); int l_ = __builtin_amdgcn_mbcnt_hi(~0u, __builtin_amdgcn_mbcnt_lo(~0u, 0u)); asm volatile("" : "+v"(l_)); F.lane = l_; F.wave = w_; F.tid = w_ * 64 + l_; \
        int g_ = gridDim.x, bx_ = blockIdx.x; asm volatile("" : "+s"(g_), "+s"(bx_)); F.G = g_; F.vcu = (g_ % 8 == 0) ? (bx_ % 8) * (g_ / 8) + bx_ / 8 : bx_; \
        F.ws = p.ws; \
        run_phase<(k)>(p, F); }
#define SEAM() xcd_barrier(bar, (wave_s == 0) && (__builtin_amdgcn_mbcnt_hi(~0u, __builtin_amdgcn_mbcnt_lo(~0u, 0u)) == 0))
    RUN_PHASE(0) SEAM();
    RUN_PHASE(1) SEAM(); RUN_PHASE(2) SEAM(); RUN_PHASE(3) SEAM(); RUN_PHASE(4) SEAM(); RUN_PHASE(5) SEAM(); RUN_PHASE(6) SEAM(); RUN_PHASE(7) SEAM(); RUN_PHASE(8) SEAM();
    RUN_PHASE(9) SEAM(); RUN_PHASE(10) SEAM(); RUN_PHASE(11) SEAM(); RUN_PHASE(12) SEAM(); RUN_PHASE(13) SEAM(); RUN_PHASE(14) SEAM(); RUN_PHASE(15) SEAM(); RUN_PHASE(16) SEAM();
    RUN_PHASE(17) SEAM(); RUN_PHASE(19) SEAM(); RUN_PHASE(21) SEAM(); RUN_PHASE(22)
#undef RUN_PHASE
#undef SEAM
}

extern "C" void kernel_launch(void* const* d_in, const int* in_sizes, int n_in, void* d_out, int out_size, void* d_ws, size_t ws_size, hipStream_t stream) {
    static int grid_blocks = 0;
    if (grid_blocks == 0) {
        if (n_in != 27 || out_size != NLAT * D || ws_size < WS_END) { fprintf(stderr, "kernel_launch: unexpected problem (n_in %d out %d ws %zu, need %zu)\n", n_in, out_size, ws_size, (size_t)WS_END); grid_blocks = -1; return; }
        int dev = 0, cus = 0, per_cu = 0;
        hipGetDevice(&dev);
        hipDeviceGetAttribute(&cus, hipDeviceAttributeMultiprocessorCount, dev);
        hipFuncSetAttribute((const void*)fwd_kernel, hipFuncAttributeMaxDynamicSharedMemorySize, LDS_BYTES);
        hipOccupancyMaxActiveBlocksPerMultiprocessor(&per_cu, (const void*)fwd_kernel, 512, LDS_BYTES);
        if (per_cu < 1) { fprintf(stderr, "kernel_launch: occupancy query reports %d blocks per CU\n", per_cu); grid_blocks = -1; return; }
        grid_blocks = cus;
        if (grid_blocks < 256) { fprintf(stderr, "kernel_launch: needs >= 256 CUs, got %d\n", grid_blocks); grid_blocks = -1; return; }
    }
    if (grid_blocks < 0) return;
    if (hipMemsetAsync((char*)d_ws + WS_BAR, 0, (WS_XCNT - WS_BAR) + 6 * 64 * 256, stream) != hipSuccess) { fprintf(stderr, "kernel_launch: memset of the barrier words failed\n"); return; }
    Params p{};
    const float** pp = (const float**)&p;
    for (int i = 0; i < 27; ++i) pp[i] = (const float*)d_in[i];
    p.out = (float*)d_out; p.ws = (unsigned char*)d_ws; p.ph_lo = 0; p.ph_hi = 24;
    void* args[] = {&p};
    hipError_t e = hipLaunchCooperativeKernel((const void*)fwd_kernel, dim3(grid_blocks), dim3(512), args, LDS_BYTES, stream);
    if (e != hipSuccess) fprintf(stderr, "cooperative launch failed: %s (grid %d)\n", hipGetErrorString(e), grid_blocks);
}
```

```cpp
#include <hip/hip_runtime.h>
#include <hip/hip_cooperative_groups.h>
#include <cstdio>
#include <cstdint>
namespace cg = cooperative_groups;

#define LAS __attribute__((address_space(3)))
typedef unsigned short bf16_t;
typedef short bf16x8 __attribute__((ext_vector_type(8)));
typedef short s16x4 __attribute__((ext_vector_type(4)));
typedef float f32x4 __attribute__((ext_vector_type(4)));
typedef float f32x16 __attribute__((ext_vector_type(16)));
typedef unsigned u32x4 __attribute__((ext_vector_type(4)));
typedef unsigned u32x2 __attribute__((ext_vector_type(2)));

constexpr int D = 1024, NB = 8, TL = 2048, TC = 256, NLAT = NB * TL, NCTX = NB * TC, NROW = NLAT + NCTX;
constexpr int FF = 2816, NMOD = 9;
constexpr int EV_LD = 1792, OD_LD = 2304, KVT = TL + TC;
constexpr float EPS = 1e-6f;
constexpr float LAM_INIT = 0.35550906759f;
constexpr float QSCALE = 0.125f * 1.4426950408889634f;

constexpr size_t MiB = 1u << 20;
constexpr size_t WS_MOD = 0;
constexpr size_t WS_BAR = 768 * 1024;
constexpr size_t WS_ROPE = 1 * MiB;
constexpr size_t WS_CSC = 1 * MiB + 512 * 1024;
constexpr size_t WS_HC = 2 * MiB;
constexpr size_t WS_W0 = 10 * MiB;
constexpr size_t W_F1I = 0, W_F1O = 11 * MiB, W_F2I = 16 * MiB + 512 * 1024, W_F2O = 27 * MiB + 512 * 1024, W_MO = 33 * MiB, W_LAYER = 35 * MiB;
constexpr size_t WS_CS = WS_W0;
constexpr size_t WS_WEV = 80 * MiB;
constexpr size_t WS_WEVV = WS_WEV + 3 * MiB + 512 * 1024;
constexpr size_t WS_WPQ = 85 * MiB;
constexpr size_t WS_WOD = 86 * MiB;
constexpr size_t WS_WODV = WS_WOD + 4 * MiB + 512 * 1024;
constexpr size_t WS_A = 92 * MiB;
constexpr size_t WS_ACT = 128 * MiB;
constexpr size_t WS_OF = 191 * MiB;
constexpr size_t WS_FP1 = 218 * MiB;
constexpr size_t WS_VT = 227 * MiB;
constexpr size_t WS_PQT = 254 * MiB;
constexpr size_t WS_PQTC = 270 * MiB;
constexpr size_t WS_OB = 272 * MiB;
constexpr size_t WS_PART = 227 * MiB;
constexpr size_t WS_XCNT = 800 * 1024;
constexpr size_t WS_XBUF = 299 * MiB;
constexpr size_t WS_A2 = 227 * MiB;
constexpr size_t WS_END = 300 * MiB;

constexpr int LDS_BYTES = 131072 + 1024;

struct Params {
    const float *x, *c, *ctx, *c_ctx, *ada_w, *ada_b, *norm_ffn1, *norm_mix, *norm_ffn2, *ffn1_w_in, *ffn1_w_out, *ffn2_w_in, *ffn2_w_out,
        *mix_w_out, *even_w_in, *gla_gate_w, *gla_gate_b, *gla_norm, *odd_w_in, *conv_w, *conv_b, *lq1, *lk1, *lq2, *lk2, *diff_norm, *final_norm;
    float* out; unsigned char* ws; int ph_lo, ph_hi;
};

typedef const __attribute__((address_space(4))) Params KParams;
typedef KParams& PRef;
__device__ __forceinline__ float bf2f(unsigned h) { return __uint_as_float(h << 16); }
typedef float f32x2_t __attribute__((ext_vector_type(2))); typedef __bf16 bf16x2_t __attribute__((ext_vector_type(2)));
__device__ __forceinline__ unsigned cvt_pk_bf16(float lo, float hi) { f32x2_t v = {lo, hi}; bf16x2_t b = __builtin_convertvector(v, bf16x2_t); return __builtin_bit_cast(unsigned, b); }
__device__ __forceinline__ unsigned f2bf(float f) { return cvt_pk_bf16(f, 0.f) & 0xffffu; }
__device__ __forceinline__ unsigned pk2(float lo, float hi) { return cvt_pk_bf16(lo, hi); }
__device__ __forceinline__ float silu_f(float x) { return x / (1.0f + __expf(-x)); }
__device__ __forceinline__ float wave_sum(float v) {
#pragma unroll
    for (int o = 1; o < 64; o <<= 1) v += __shfl_xor(v, o);
    return v;
}
#define DPPF(x, ctrl, rm, bm) __int_as_float(__builtin_amdgcn_update_dpp(0, __float_as_int(x), ctrl, rm, bm, false))
#define MFMA16(a, b, c) __builtin_amdgcn_mfma_f32_16x16x32_bf16(a, b, c, 0, 0, 0)
#define MFMA32(a, b, c) __builtin_amdgcn_mfma_f32_32x32x16_bf16(a, b, c, 0, 0, 0)

namespace pg8 {
constexpr int BM = 256, BK = 64, HALF = 128, HTB = HALF * BK * 2, STAGE_BYTES = 8 * HTB;
__device__ __forceinline__ int lds_byte(int r, int c) { const int st = (r >> 4) * 2 + (c >> 5), rr = r & 15, cc = c & 31, ob = rr * 64 + cc * 2; return st * 1024 + (ob ^ (((ob >> 9) & 1) << 5)); }
__device__ __forceinline__ void stage_rc(int b, int& R, int& C) { const int st = b / 1024, sb = b % 1024, swz = sb ^ (((sb >> 9) & 1) << 5); R = (st >> 1) * 16 + swz / 64; C = (st & 1) * 32 + (swz % 64) / 2; }
__device__ __forceinline__ int perm32(int rho) { const int n = rho >> 4, i = rho & 15; return 8 * (i >> 2) + 4 * n + (i & 3); }

struct Unit { const char* a; const char* b; int pm, pn, tag, half; };
struct Seg { unsigned A, B, dims; };
__device__ __forceinline__ Seg mkseg(unsigned A, unsigned B, int nM, int nN, int pm0, int pn0, int tag) { Seg s; s.A = A; s.B = B; s.dims = (unsigned)nM | ((unsigned)nN << 8) | ((unsigned)pm0 << 16) | ((unsigned)pn0 << 24) | ((unsigned)tag << 28); return s; }
struct Sched {
    Seg s0, s1, s2; int G, vcu, coff; unsigned tstep; const char* ws;
    int nfull;
    int parts, kpart, kbase, pbase;
    __device__ __forceinline__ bool dec(const Seg& s, int& L, Unit& u) const {
        const int nM = s.dims & 255, nN = (s.dims >> 8) & 255;
        const int n = nM * nN;
        if (L < n) {
            const int idx = L, nig = 8 * nN, gid = idx / nig, fm = gid * 8, gsz = (nM - fm) < 8 ? (nM - fm) : 8;
            const int pm = fm + ((idx % nig) % gsz), pn = (idx % nig) / gsz;
            u.pm = (int)((s.dims >> 16) & 255) + pm; u.pn = (int)((s.dims >> 24) & 15) + pn; u.tag = (int)(s.dims >> 28); u.a = ws + s.A + (size_t)u.pm * tstep; u.b = ws + s.B + (size_t)u.pn * tstep; return true;
        }
        L -= n; return false;
    }
    __device__ __forceinline__ bool next(int i, Unit& u) const {
        int L = i * G + vcu - coff; if (L < 0) return false;
        u.half = 0; int hsel = -1;
        if (nfull > 0 && L >= nfull) { const int hl = L - nfull; hsel = hl & 1; L = nfull + (hl >> 1); }
        if (parts > 1) { const int part = L % parts; L /= parts; if (!dec(s0, L, u)) return false;
            const size_t ko = (size_t)(kbase + part * kpart) * 2; u.a += ko; u.b += ko; u.tag = pbase + part; return true; }
        if (!(dec(s0, L, u) || dec(s1, L, u) || dec(s2, L, u))) return false;
        if (hsel >= 0) { u.half = 1 + hsel; u.a += (size_t)hsel * (tstep >> 1); }
        return true;
    }
};

enum { T_SWIGLU = 0, T_ZEV = 1, T_ZODD = 2, T_TRV = 3, T_TRPQ = 4, T_FOUR = 5, T_FOURC = 6, T_FOUR2 = 7 };
struct EpiT {
    static constexpr bool PERM = true, AFTER_DRAIN = false;
    unsigned char* ws; unsigned dst_off; int ldc;
    __device__ __forceinline__ void operator()(const f32x4 (&acc)[2][2][4][2], const Unit& u, int wr, int wc, int fr, int fq) const {
        bf16_t* dst = (bf16_t*)(ws + dst_off); bf16_t* vt = (bf16_t*)(ws + WS_VT); bf16_t* pqt = (bf16_t*)(ws + WS_PQT); bf16_t* pqtc = (bf16_t*)(ws + WS_PQTC); const float* rope = (const float*)(ws + WS_ROPE);
        const int lr0 = wr * 64 + fr;
        const int lc0 = wc * 32 + 8 * fq;
        if (u.tag == T_SWIGLU) {
            const int rsh = (u.half == 2) ? HALF : 0;
#pragma unroll
            for (int ai = 0; ai < 2; ++ai)
#pragma unroll
                for (int m = 0; m < 4; ++m) {
                    if (ai == 1 && u.half != 0) continue;
                    bf16_t* rowp = dst + (size_t)(u.pm * BM + rsh + lr0 + ai * HALF + m * 16) * ldc + u.pn * HALF + lc0;
                    float o[8];
#pragma unroll
                    for (int n = 0; n < 2; ++n)
#pragma unroll
                        for (int e = 0; e < 4; e += 2) {
                            const f32x2_t g2 = (f32x2_t){acc[ai][0][m][n][e], acc[ai][0][m][n][e + 1]}, u2 = (f32x2_t){acc[ai][1][m][n][e], acc[ai][1][m][n][e + 1]};
                            const f32x2_t t2 = g2 * -1.4426950408889634f; const f32x2_t d2 = (f32x2_t){__builtin_amdgcn_exp2f(t2.x), __builtin_amdgcn_exp2f(t2.y)} + 1.0f;
                            const f32x2_t r2 = (g2 * u2) * (f32x2_t){__builtin_amdgcn_rcpf(d2.x), __builtin_amdgcn_rcpf(d2.y)}; o[n * 4 + e] = r2.x; o[n * 4 + e + 1] = r2.y; }
                    u32x4 w; w.x = cvt_pk_bf16(o[0], o[1]); w.y = cvt_pk_bf16(o[2], o[3]); w.z = cvt_pk_bf16(o[4], o[5]); w.w = cvt_pk_bf16(o[6], o[7]);
                    *(u32x4*)rowp = w;
                    asm volatile("" ::: "memory");
                }
        } else if (u.tag == T_ZEV || u.tag == T_ZODD || u.tag == T_FOUR || u.tag == T_FOURC || u.tag == T_FOUR2) {
            float sc = 1.f; bool rp = false; size_t rbase; int cbase = u.pn * BM; int ldo = ldc;
            if (u.tag == T_ZODD) { rbase = (size_t)u.pm * BM; if (u.pn >= 3 && u.pn < 6) sc = QSCALE; rp = (u.pn >= 3) && (u.pm < 64); }
            else if (u.tag == T_ZEV) rbase = (size_t)u.pm * BM;
            else if (u.tag == T_FOUR) { rbase = (size_t)u.pn * TL + (size_t)u.pm * BM; cbase = 0; sc = 0.00276213586400995f; }
            else if (u.tag == T_FOUR2) { rbase = (size_t)u.pn * TL + (size_t)u.pm * BM; cbase = 0; sc = 0.00276213586400995f; dst = (bf16_t*)(ws + WS_FP1); ldo = 256; }
            else { rbase = (size_t)NLAT + (size_t)u.pn * TC; cbase = 0; sc = 0.0078125f; }
#pragma unroll
            for (int ai = 0; ai < 2; ++ai)
#pragma unroll
                for (int m = 0; m < 4; ++m) {
                    if (ai == 1 && u.half != 0) continue;
                    const size_t row = rbase + ((u.half == 2) ? HALF : 0) + lr0 + ai * HALF + m * 16;
                    bf16_t* rowp = dst + row * ldo + cbase + lc0;
                    f32x4 cs[2], sn[2];
                    if (rp) {
                        const int t = (int)(row & (TL - 1)); const float* rt = rope + t * 64 + (wc & 1) * 16 + 8 * (fq & 1);
                        cs[0] = *(const f32x4*)(rt); cs[1] = *(const f32x4*)(rt + 4); sn[0] = *(const f32x4*)(rt + 32); sn[1] = *(const f32x4*)(rt + 36);
                    }
#pragma unroll
                    for (int bj = 0; bj < 2; ++bj) {
                        float o[8];
#pragma unroll
                        for (int n = 0; n < 2; ++n)
#pragma unroll
                            for (int e = 0; e < 4; ++e) {
                                float v = acc[ai][bj][m][n][e];
                                if (rp) { const float pv = __shfl_xor(v, 32); const float sg = (fq < 2) ? -sn[n][e] : sn[n][e]; v = v * cs[n][e] + pv * sg; }
                                o[n * 4 + e] = v * sc;
                            }
                        u32x4 w; w.x = cvt_pk_bf16(o[0], o[1]); w.y = cvt_pk_bf16(o[2], o[3]); w.z = cvt_pk_bf16(o[4], o[5]); w.w = cvt_pk_bf16(o[6], o[7]);
                        *(u32x4*)(rowp + bj * HALF) = w;
                    }
                    asm volatile("" ::: "memory");
                }
        } else {
            const bool lat = u.pn < 64; const int b = lat ? (u.pn >> 3) : (u.pn - 64);
            bf16_t* base; size_t pitch; int k0;
            if (u.tag == T_TRV) { base = vt + (size_t)b * 768 * KVT + (size_t)(u.pm * BM) * KVT; pitch = KVT; k0 = lat ? (u.pn & 7) * 256 : TL; }
            else if (lat) { base = pqt + (size_t)b * 256 * 4096; pitch = 4096; k0 = u.pm * TL + (u.pn & 7) * 256; }
            else { base = pqtc + (size_t)b * 256 * 512; pitch = 512; k0 = u.pm * TC; }
#pragma unroll
            for (int ai = 0; ai < 2; ++ai)
#pragma unroll
                for (int m = 0; m < 4; ++m) {
                    if (ai == 1 && u.half != 0) continue;
                    bf16_t* rowp = base + (size_t)(((u.half == 2) ? HALF : 0) + lr0 + ai * HALF + m * 16) * pitch + k0 + lc0;
#pragma unroll
                    for (int bj = 0; bj < 2; ++bj) {
                        const f32x4 v0 = acc[ai][bj][m][0], v1 = acc[ai][bj][m][1];
                        u32x4 w; w.x = cvt_pk_bf16(v0[0], v0[1]); w.y = cvt_pk_bf16(v0[2], v0[3]); w.z = cvt_pk_bf16(v1[0], v1[1]); w.w = cvt_pk_bf16(v1[2], v1[3]);
                        *(u32x4*)(rowp + bj * HALF) = w;
                    }
                }
        }
    }
};
struct EpiR {
    static constexpr bool PERM = false, AFTER_DRAIN = false;
    const float* in_lat; const float* in_ctx; float* out_lat; float* out_ctx; const float* gate; float coef;
    __device__ __forceinline__ void operator()(const f32x4 (&acc)[2][2][4][2], const Unit& u, int wr, int wc, int fr, int fq) const {
        const bool lat = u.pm < 64; const int cond = lat ? (u.pm >> 3) : 8;
        const float* ib = lat ? in_lat + (size_t)u.pm * BM * D : in_ctx + (size_t)(u.pm - 64) * BM * D;
        float* ob = lat ? out_lat + (size_t)u.pm * BM * D : out_ctx + (size_t)(u.pm - 64) * BM * D;
        const int col0 = u.pn * BM + wc * 32 + 4 * fq; const float* gp = gate + (size_t)cond * (NMOD * D) + col0;
        f32x4 gv[2][2];
#pragma unroll
        for (int bj = 0; bj < 2; ++bj)
#pragma unroll
            for (int n = 0; n < 2; ++n) gv[bj][n] = *(const f32x4*)(gp + bj * HALF + n * 16) * coef;
#pragma unroll
        for (int ai = 0; ai < 2; ++ai)
#pragma unroll
            for (int m = 0; m < 4; ++m) {
                const size_t off = (size_t)(ai * HALF + wr * 64 + m * 16 + fr) * D + col0;
#pragma unroll
                for (int bj = 0; bj < 2; ++bj)
#pragma unroll
                    for (int n = 0; n < 2; ++n) { const f32x4 hv = *(const f32x4*)(ib + off + bj * HALF + n * 16); *(f32x4*)(ob + off + bj * HALF + n * 16) = hv + gv[bj][n] * acc[ai][bj][m][n]; }
            }
    }
};

struct EpiP {
    static constexpr bool PERM = false, AFTER_DRAIN = false;
    bf16_t* P;
    __device__ __forceinline__ void operator()(const f32x4 (&acc)[2][2][4][2], const Unit& u, int wr, int wc, int fr, int fq) const {
        int fr_ = fr, fq_ = fq; asm volatile("" : "+v"(fr_), "+v"(fq_));
        bf16_t* base = P + ((size_t)u.tag * NCTX + (size_t)(u.pm - 64) * BM) * D + u.pn * BM + wc * 32 + 4 * fq_;
#pragma unroll
        for (int ai = 0; ai < 2; ++ai)
#pragma unroll
            for (int m = 0; m < 4; ++m) {
                bf16_t* rp = base + (size_t)(ai * HALF + wr * 64 + m * 16 + fr_) * D;
#pragma unroll
                for (int bj = 0; bj < 2; ++bj)
#pragma unroll
                    for (int n = 0; n < 2; ++n) { const f32x4 v = acc[ai][bj][m][n]; u32x2 w; w.x = cvt_pk_bf16(v[0], v[1]); w.y = cvt_pk_bf16(v[2], v[3]); *(u32x2*)(rp + bj * HALF + n * 16) = w; }
            }
    }
};

struct EpiRN {
    static constexpr bool PERM = false, AFTER_DRAIN = true;
    const float* in; const float* gate; float* outf; const float* gfin;
    float* hout; bf16_t* aout; const float* gain; const float* scsh;
    float* xbuf; unsigned* cnt; float coef; int mode;
    __device__ __forceinline__ void fused(f32x4 (&acc)[2][2][4][2], const Unit& u, int wr, int wc, int fr, int fq, LAS unsigned char* lds, int wid, int lane) const {
        LAS float* P = (LAS float*)lds;
        LAS float* S = (LAS float*)(lds + 4096);
        const int cond = u.pm >> 3;
        const int col0 = u.pn * BM + wc * 32 + 4 * fq;
        const float* ib = in + (size_t)u.pm * BM * D;
        const float* gp = gate + (size_t)cond * (NMOD * D) + col0;
        f32x4 gv[2][2];
#pragma unroll
        for (int bj = 0; bj < 2; ++bj)
#pragma unroll
            for (int n = 0; n < 2; ++n) gv[bj][n] = *(const f32x4*)(gp + bj * HALF + n * 16) * coef;
#pragma unroll
        for (int ai = 0; ai < 2; ++ai)
#pragma unroll
            for (int m = 0; m < 4; ++m) {
                const int lrow = ai * HALF + wr * 64 + m * 16 + fr; const size_t off = (size_t)lrow * D + col0; float ss = 0.f;
#pragma unroll
                for (int bj = 0; bj < 2; ++bj)
#pragma unroll
                    for (int n = 0; n < 2; ++n) { const f32x4 hn = *(const f32x4*)(ib + off + bj * HALF + n * 16) + gv[bj][n] * acc[ai][bj][m][n]; acc[ai][bj][m][n] = hn;
                        ss += (hn[0] * hn[0] + hn[1] * hn[1]) + (hn[2] * hn[2] + hn[3] * hn[3]); }
                ss += __shfl_xor(ss, 16); ss += __shfl_xor(ss, 32);
                if (fq == 0) P[lrow * 4 + wc] = ss;
                if (m & 1) asm volatile("" ::: "memory");
            }
        __syncthreads();
        const int row = wid * 32 + (lane & 31);
        float* slot = xbuf + ((size_t)(u.pm * BM + row) * 4);
        if (lane < 32) { const float t = (P[row * 4 + 0] + P[row * 4 + 1]) + (P[row * 4 + 2] + P[row * 4 + 3]);
            __hip_atomic_store(slot + u.pn, t, __ATOMIC_RELAXED, __HIP_MEMORY_SCOPE_AGENT); }
        asm volatile("s_waitcnt vmcnt(0)" ::: "memory");
        if (lane == 0) __hip_atomic_fetch_add(cnt + 64 * u.pm, 1u, __ATOMIC_RELAXED, __HIP_MEMORY_SCOPE_AGENT);
        if (wid == 0) {
            unsigned sp = 0;
            while ((unsigned)__builtin_amdgcn_readfirstlane(__hip_atomic_load(cnt + 64 * u.pm, __ATOMIC_RELAXED, __HIP_MEMORY_SCOPE_AGENT)) < 32u) { __builtin_amdgcn_s_sleep(2); if (++sp > (1u << 22)) break; }
            __builtin_amdgcn_fence(__ATOMIC_ACQUIRE, "agent");
        }
        asm volatile("s_waitcnt vmcnt(0) lgkmcnt(0)" ::: "memory");
        __syncthreads();
        if (lane < 32) { float q = 0.f;
#pragma unroll
            for (int t = 0; t < 4; ++t) q += __hip_atomic_load(slot + t, __ATOMIC_RELAXED, __HIP_MEMORY_SCOPE_AGENT);
            S[row] = rsqrtf(q * (1.f / D) + EPS); }
        __syncthreads();
        f32x4 g0[2][2], g1[2][2];
#pragma unroll
        for (int bj = 0; bj < 2; ++bj)
#pragma unroll
            for (int n = 0; n < 2; ++n) { const int c = col0 + bj * HALF + n * 16;
                if (mode == 0) { g0[bj][n] = *(const f32x4*)(gfin + c); g1[bj][n] = (f32x4){0.f, 0.f, 0.f, 0.f}; }
                else { const float* sp_ = scsh + (size_t)cond * (NMOD * D) + c; g0[bj][n] = *(const f32x4*)(gain + c) * (*(const f32x4*)(sp_ + D) + 1.0f); g1[bj][n] = *(const f32x4*)(sp_); } }
#pragma unroll
        for (int ai = 0; ai < 2; ++ai)
#pragma unroll
            for (int m = 0; m < 4; ++m) {
                const int lrow = ai * HALF + wr * 64 + m * 16 + fr; const size_t off = (size_t)(u.pm * BM + lrow) * D + col0; const float rs = S[lrow];
#pragma unroll
                for (int bj = 0; bj < 2; ++bj)
#pragma unroll
                    for (int n = 0; n < 2; ++n) { const f32x4 hn = acc[ai][bj][m][n]; const f32x4 y = (hn * rs) * g0[bj][n] + g1[bj][n];
                        if (mode == 0) *(f32x4*)(outf + off + bj * HALF + n * 16) = y;
                        else { *(f32x4*)(hout + off + bj * HALF + n * 16) = hn; u32x2 w; w.x = cvt_pk_bf16(y[0], y[1]); w.y = cvt_pk_bf16(y[2], y[3]); *(u32x2*)(aout + off + bj * HALF + n * 16) = w; } }
                if (m & 1) asm volatile("" ::: "memory");
            }
    }
};

template <class Epi, bool HM = false>
__device__ __forceinline__ void gemm_phase(LAS unsigned char* lds, const int tid, const int K, const int ld, const Sched& S, const Epi& E) {
    const int wid = __builtin_amdgcn_readfirstlane(tid >> 6), lane = tid & 63, wr = wid >> 2, wc = wid & 3, fr = lane & 15, fq = lane >> 4;
    const int nt = K / BK;
    unsigned voffA[2], voffB[2];
#pragma unroll
    for (int i = 0; i < 2; ++i) { int R, C; stage_rc(tid * 16 + i * 8192, R, C); const int Rb = Epi::PERM ? ((R & ~31) + perm32(R & 31)) : R;
        voffA[i] = (unsigned)(R * ld + C) * 2u; voffB[i] = (unsigned)(Rb * ld + C) * 2u; }
    const size_t kstep = (size_t)(BK * 2);
    const size_t hstep = (size_t)HALF * ld * 2;
    const unsigned ldsw = (unsigned)wid * 1024u;
    const int aoff = lds_byte(wr * 64 + fr, fq * 8), boff = lds_byte(wc * 32 + fr, fq * 8);
#define PG8_SA(b, h) (((b) * 2 + (h)) * HTB)
#define PG8_SB(b, h) ((4 + (b) * 2 + (h)) * HTB)
#define PG8_STAGE(bufoff, gbase, voff) do { _Pragma("unroll") for (int _i = 0; _i < 2; ++_i) \
        __builtin_amdgcn_global_load_lds((const unsigned*)((const char*)(gbase) + (voff)[_i]), (LAS unsigned*)(lds + (bufoff) + ldsw + _i * 8192), 16, 0, 0); } while (0)
#define PG8_LDA(dst, b, h) do { _Pragma("unroll") for (int m = 0; m < 4; ++m) _Pragma("unroll") for (int k = 0; k < 2; ++k) dst[m][k] = *(const LAS bf16x8*)(lds + PG8_SA(b, h) + aoff + m * 2048 + k * 1024); } while (0)
#define PG8_LDB(dst, b, h) do { _Pragma("unroll") for (int n = 0; n < 2; ++n) _Pragma("unroll") for (int k = 0; k < 2; ++k) dst[n][k] = *(const LAS bf16x8*)(lds + PG8_SB(b, h) + boff + n * 2048 + k * 1024); } while (0)
#define PG8_MMA(ai, bj, At, Bt) do { __builtin_amdgcn_s_setprio(1); _Pragma("unroll") for (int m = 0; m < 4; ++m) _Pragma("unroll") for (int n = 0; n < 2; ++n) _Pragma("unroll") for (int k = 0; k < 2; ++k) \
        acc[ai][bj][m][n] = __builtin_amdgcn_mfma_f32_16x16x32_bf16(Bt[n][k], At[m][k], acc[ai][bj][m][n], 0, 0, 0); __builtin_amdgcn_s_setprio(0); } while (0)
#define PG8_WAIT_V(n) asm volatile("s_waitcnt vmcnt(" #n ")" ::: "memory")
#define PG8_WAIT_L(n) asm volatile("s_waitcnt lgkmcnt(" #n ")" ::: "memory")
#define PG8_BAR __builtin_amdgcn_s_barrier()
#define PG8_SCHED __builtin_amdgcn_sched_barrier(0)
    Unit cur, nxt; int ui = 0;
    if (!S.next(0, cur)) return;
    f32x4 acc[2][2][4][2];
#pragma unroll
    for (int a = 0; a < 2; ++a)
#pragma unroll
        for (int b = 0; b < 2; ++b)
#pragma unroll
            for (int m = 0; m < 4; ++m)
#pragma unroll
                for (int n = 0; n < 2; ++n) acc[a][b][m][n] = (f32x4){0.f, 0.f, 0.f, 0.f};
    bf16x8 At[4][2], B0[2][2], B1[2][2];
    const char* cA = cur.a; const char* cB = cur.b;
    PG8_STAGE(PG8_SB(0, 0), cB, voffB); PG8_STAGE(PG8_SB(0, 1), cB + hstep, voffB); PG8_STAGE(PG8_SA(0, 0), cA, voffA); PG8_STAGE(PG8_SA(0, 1), cA + hstep, voffA);
    if (wr == 1) PG8_BAR;
    PG8_WAIT_V(2); PG8_BAR;
    PG8_STAGE(PG8_SB(1, 0), cB + kstep, voffB); PG8_STAGE(PG8_SA(1, 0), cA + kstep, voffA); PG8_STAGE(PG8_SB(1, 1), cB + hstep + kstep, voffB);
    PG8_WAIT_V(6); PG8_BAR;
    for (;;) {
        const bool hm = HM && (cur.half != 0);
        const bool has_next = S.next(ui + 1, nxt);
        const char* nA = has_next ? nxt.a : cA; const char* nB = has_next ? nxt.b : cB;
        for (int t = 0; t < nt; t += 2) {
            const bool last = (t == nt - 2);
            const char* a1 = cA + (size_t)(t + 1) * kstep;
            const char* a2 = last ? nA : cA + (size_t)(t + 2) * kstep; const char* b2 = last ? nB : cB + (size_t)(t + 2) * kstep;
            const char* a3 = a2 + kstep; const char* b3 = b2 + kstep;
            PG8_LDB(B0, 0, 0); PG8_LDB(B1, 0, 1); PG8_SCHED; PG8_LDA(At, 0, 0); PG8_STAGE(PG8_SA(1, 1), a1 + hstep, voffA);
            PG8_WAIT_V(8); PG8_WAIT_L(0); PG8_BAR; PG8_MMA(0, 0, At, B0); PG8_MMA(0, 1, At, B1); PG8_BAR; PG8_SCHED;
            if (!HM || !hm) PG8_LDA(At, 0, 1); PG8_STAGE(PG8_SB(0, 0), b2, voffB); PG8_STAGE(PG8_SB(0, 1), b2 + hstep, voffB); PG8_STAGE(PG8_SA(0, 0), a2, voffA);
            PG8_WAIT_V(8); PG8_WAIT_L(0); PG8_BAR; if (!HM || !hm) { PG8_MMA(1, 0, At, B0); PG8_MMA(1, 1, At, B1); } PG8_BAR; PG8_SCHED;
            PG8_LDB(B0, 1, 0); PG8_LDB(B1, 1, 1); PG8_SCHED; PG8_LDA(At, 1, 0); PG8_STAGE(PG8_SA(0, 1), a2 + hstep, voffA);
            PG8_WAIT_V(8); PG8_WAIT_L(0); PG8_BAR; PG8_MMA(0, 0, At, B0); PG8_MMA(0, 1, At, B1); PG8_BAR; PG8_SCHED;
            if (!HM || !hm) PG8_LDA(At, 1, 1); PG8_STAGE(PG8_SB(1, 0), b3, voffB); PG8_STAGE(PG8_SB(1, 1), b3 + hstep, voffB); PG8_STAGE(PG8_SA(1, 0), a3, voffA);
            PG8_WAIT_V(8); PG8_WAIT_L(0); PG8_BAR; if (!HM || !hm) { PG8_MMA(1, 0, At, B0); PG8_MMA(1, 1, At, B1); } PG8_BAR; PG8_SCHED;
        }
        if (wr == 0) PG8_BAR;
        if constexpr (!Epi::AFTER_DRAIN) E(acc, cur, wr, wc, fr, fq);
        if (!has_next) break;
#pragma unroll
        for (int a = 0; a < 2; ++a)
#pragma unroll
            for (int b = 0; b < 2; ++b)
#pragma unroll
                for (int m = 0; m < 4; ++m)
#pragma unroll
                    for (int n = 0; n < 2; ++n) acc[a][b][m][n] = (f32x4){0.f, 0.f, 0.f, 0.f};
        cur = nxt; cA = nA; cB = nB; ++ui;
        if (wr == 1) PG8_BAR;
    }
    PG8_WAIT_V(0);
    PG8_BAR;
    if constexpr (Epi::AFTER_DRAIN) E.fused(acc, cur, wr, wc, fr, fq, lds, wid, lane);
#undef PG8_SA
#undef PG8_SB
#undef PG8_STAGE
#undef PG8_LDA
#undef PG8_LDB
#undef PG8_MMA
#undef PG8_WAIT_V
#undef PG8_WAIT_L
#undef PG8_BAR
#undef PG8_SCHED
}
}

struct Frame {
    LAS unsigned char* lds; int tid, lane, wave, vcu, G;
    unsigned char* ws;
};
#define F_MOD ((float*)(F.ws + WS_MOD))
#define F_ROPE ((float*)(F.ws + WS_ROPE))
#define F_HC ((float*)(F.ws + WS_HC))
#define F_ABUF ((bf16_t*)(F.ws + WS_A))
#define F_ACT ((bf16_t*)(F.ws + WS_ACT))
#define F_VT ((bf16_t*)(F.ws + WS_VT))
#define F_PQT ((bf16_t*)(F.ws + WS_PQT))
#define F_PQTC ((bf16_t*)(F.ws + WS_PQTC))
#define F_OF ((bf16_t*)(F.ws + WS_OF))
#define F_OB ((bf16_t*)(F.ws + WS_OB))
#define F_CS ((bf16_t*)(F.ws + WS_CS))
#define F_CSC ((bf16_t*)(F.ws + WS_CSC))

__device__ __forceinline__ void mod_table(PRef p, Frame& F) {
    LAS float* sl = (LAS float*)F.lds;
    for (int i = F.tid; i < 9 * 1024; i += 512) { const int cond = i >> 10, k = i & 1023; const float v = cond < 8 ? p.c[cond * 1024 + k] : p.c_ctx[k]; sl[i] = silu_f(v); }
    __syncthreads();
}
__device__ __forceinline__ void mod_item(PRef p, Frame& F, int item) {
    LAS float* sl = (LAS float*)F.lds;
    LAS float* red = sl + 9 * 1024;
    const int l = item / 288, cb = item % 288, tid = F.tid;
    const int cq = tid & 7, kq = tid >> 3;
    const float* W = p.ada_w + (size_t)l * D * (NMOD * D) + 32 * cb + 4 * cq;
    f32x4 acc[9];
#pragma unroll
    for (int j = 0; j < 9; ++j) acc[j] = (f32x4){0.f, 0.f, 0.f, 0.f};
#pragma unroll 4
    for (int kk = 0; kk < 16; ++kk) {
        const int k = kq * 16 + kk; const f32x4 w = *(const f32x4*)(W + (size_t)k * (NMOD * D));
#pragma unroll
        for (int j = 0; j < 9; ++j) acc[j] += w * sl[j * 1024 + k];
    }
#pragma unroll
    for (int j = 0; j < 9; ++j)
#pragma unroll
        for (int e = 0; e < 4; ++e) red[(kq * 9 + j) * 32 + 4 * cq + e] = acc[j][e];
    __syncthreads();
    if (tid < 9 * 32) {
        const int j = tid >> 5, cc = tid & 31; float s = 0.f;
#pragma unroll 8
        for (int q = 0; q < 64; ++q) s += red[(q * 9 + j) * 32 + cc];
        F_MOD[(size_t)(l * 9 + j) * (NMOD * D) + 32 * cb + cc] = s + p.ada_b[l * (NMOD * D) + 32 * cb + cc];
    }
    __syncthreads();
}
__device__ __forceinline__ void tr_item(const float* W, int N, int K, int k0, int n0, bf16_t* drow, LAS float* scr, int lane) {
#pragma unroll 8
    for (int i = 0; i < 32; ++i) { const int kk = 2 * i + (lane >> 5); scr[kk * 33 + (lane & 31)] = W[(size_t)(k0 + kk) * N + n0 + (lane & 31)]; }
    asm volatile("s_waitcnt lgkmcnt(0)" ::: "memory");
    const int c = lane & 7;
#pragma unroll
    for (int j = 0; j < 4; ++j) { const int n = (lane >> 3) + 8 * j; const LAS float* s = scr + (8 * c) * 33 + n;
        u32x4 o; o.x = pk2(s[0 * 33], s[1 * 33]); o.y = pk2(s[2 * 33], s[3 * 33]); o.z = pk2(s[4 * 33], s[5 * 33]); o.w = pk2(s[6 * 33], s[7 * 33]);
        *(u32x4*)(drow + (size_t)n * K + k0 + 8 * c) = o; }
    asm volatile("s_waitcnt lgkmcnt(0)" ::: "memory");
}
__device__ __forceinline__ int ffn_in_row(int n0) { return n0 < FF ? (n0 / 128) * 256 + (n0 % 128) : ((n0 - FF) / 128) * 256 + 128 + ((n0 - FF) % 128); }

__device__ __forceinline__ void prep_items(PRef p, Frame& F, const int mode, const int gw, const int NGW) {
    LAS float* scr = (LAS float*)(F.lds + F.wave * 16384);
    const int lane = F.lane;
    constexpr int I_FI = 16 * 176, I_FO = 44 * 32, I_MO = 16 * 32, I_L = 2 * I_FI + 2 * I_FO + I_MO, I_EV = 16 * 73, I_OD = 16 * 96, I_FOLD = 256;
    constexpr int NITEMS = 2 * I_L + I_EV + I_OD + I_FOLD, NEARLY = I_FI + I_FO;
    constexpr int A2 = I_FO + I_MO, NA = I_FO + I_EV + I_FOLD, NB = I_FI + I_L + I_OD;
    const int nit = mode == 0 ? I_FI : mode == 1 ? NA : mode == 3 ? A2 : NB;
    for (int it = gw; it < nit; it += NGW) {
        int r;
        if (mode == 0) r = it;
        else if (mode == 1) r = it < I_FO ? 2 * I_FI + it : it < I_FO + I_EV ? 2 * I_L + (it - I_FO) : 2 * I_L + I_EV + I_OD + (it - I_FO - I_EV);
        else if (mode == 3) r = 2 * I_FI + I_FO + it;
        else r = it < I_FI ? I_FI + it : it < I_FI + I_L ? I_L + (it - I_FI) : 2 * I_L + I_EV + (it - I_FI - I_L);
        if (r < 2 * I_L) {
            const int l = r / I_L; r -= l * I_L; unsigned char* wl = F.ws + WS_W0 + (size_t)l * W_LAYER;
            if (r < 2 * I_FI) { const int which = r / I_FI; r -= which * I_FI; const int kb = r / 176, nb = r % 176;
                const float* W = (which ? p.ffn2_w_in : p.ffn1_w_in) + (size_t)l * D * 2 * FF; bf16_t* dst = (bf16_t*)(wl + (which ? W_F2I : W_F1I));
                tr_item(W, 2 * FF, D, kb * 64, nb * 32, dst + (size_t)ffn_in_row(nb * 32) * D, scr, lane); continue; }
            r -= 2 * I_FI;
            if (r < 2 * I_FO) { const int which = r / I_FO; r -= which * I_FO; const int kb = r / 32, nb = r % 32;
                const float* W = (which ? p.ffn2_w_out : p.ffn1_w_out) + (size_t)l * FF * D; bf16_t* dst = (bf16_t*)(wl + (which ? W_F2O : W_F1O));
                tr_item(W, D, FF, kb * 64, nb * 32, dst + (size_t)(nb * 32) * FF, scr, lane); continue; }
            r -= 2 * I_FO;
            { const int kb = r / 32, nb = r % 32; const float* W = p.mix_w_out + (size_t)l * D * D; bf16_t* dst = (bf16_t*)(wl + W_MO);
              tr_item(W, D, D, kb * 64, nb * 32, dst + (size_t)(nb * 32) * D, scr, lane); continue; }
        }
        r -= 2 * I_L;
        if (r < I_EV) { const int kb = r / 73, nb = 8 + r % 73, n0 = nb * 32; bf16_t* drow;
            bf16_t* wev = (bf16_t*)(F.ws + WS_WEV); bf16_t* wevv = (bf16_t*)(F.ws + WS_WEVV);
            if (n0 < 640) drow = wev + (size_t)(n0 - 256) * D;
            else if (n0 < 1024) drow = wev + (size_t)(384 + n0 - 640) * D;
            else if (n0 < 1792) drow = wevv + (size_t)(n0 - 1024) * D;
            else if (n0 < 2560) drow = wev + (size_t)(768 + n0 - 1792) * D;
            else drow = wev + (size_t)(1536 + n0 - 2560) * D;
            tr_item(p.even_w_in, 2592, D, kb * 64, n0, drow, scr, lane); continue; }
        r -= I_EV;
        if (r < I_OD) { const int kb = r / 96, nb = r % 96, n0 = nb * 32;
            bf16_t* drow = n0 < 2304 ? (bf16_t*)(F.ws + WS_WOD) + (size_t)n0 * D : (bf16_t*)(F.ws + WS_WODV) + (size_t)(n0 - 2304) * D;
            tr_item(p.odd_w_in, 3072, D, kb * 64, n0, drow, scr, lane); continue; }
        r -= I_OD;
        {
            const int kb = r & 15, g = (r >> 4) & 3, part = r >> 6;
            for (int i = lane; i < 64; i += 64) { scr[i] = __builtin_amdgcn_cosf((float)i * (1.f / 64.f)); scr[64 + i] = __builtin_amdgcn_sinf((float)i * (1.f / 64.f)); }
            asm volatile("s_waitcnt lgkmcnt(0)" ::: "memory");
            const int k = kb * 64 + lane; const float* wr = p.even_w_in + (size_t)k * 2592 + g * 64;
            float w[64];
#pragma unroll
            for (int c4 = 0; c4 < 16; ++c4) { const f32x4 v = *(const f32x4*)(wr + 4 * c4); w[4 * c4] = v[0]; w[4 * c4 + 1] = v[1]; w[4 * c4 + 2] = v[2]; w[4 * c4 + 3] = v[3]; }
            const bool isq = part >= 2; const int k2b = (part & 1) * 32; const LAS float* tw = scr + (isq ? 64 : 0);
            bf16_t* wpq = (bf16_t*)(F.ws + WS_WPQ);
            for (int kk = 0; kk < 32; ++kk) { const int k2 = k2b + kk; float s = 0.f;
#pragma unroll
                for (int c = 0; c < 64; ++c) s += w[c] * tw[(c * k2) & 63];
                if (isq) s = -s;
                wpq[(size_t)((isq ? 256 : 0) + g * 64 + k2) * D + k] = (bf16_t)f2bf(s); }
            asm volatile("s_waitcnt lgkmcnt(0)" ::: "memory");
        }
    }
}
__device__ __forceinline__ void prep_phase(PRef p, Frame& F) {
    mod_table(p, F);
    for (int it = F.vcu; it < 576; it += F.G) mod_item(p, F, it);
    prep_items(p, F, 0, F.vcu * 8 + F.wave, F.G * 8);
    const int gt = F.vcu * 512 + F.tid, NGT = F.G * 512;
    { u32x4* z = (u32x4*)((bf16_t*)(F.ws + WS_WEV) + (size_t)1568 * D); for (int i = gt; i < 224 * D / 8; i += NGT) z[i] = (u32x4){0u, 0u, 0u, 0u}; }
    for (int i = gt; i < 256 * 512; i += NGT) { const int k1 = i >> 9, cc = i & 511, t = cc & 255; const float fr = (float)((k1 * t) & 255) * (1.f / 256.f);
        F_CSC[i] = (bf16_t)f2bf(cc < 256 ? __builtin_amdgcn_cosf(fr) : __builtin_amdgcn_sinf(fr)); }
    for (int i = gt; i < TL * 32; i += NGT) { const int t = i >> 5, j = i & 31; const float pos = (float)(j < 16 ? (t >> 6) : (t & 63));
        const float inv = __builtin_amdgcn_exp2f(-(float)(j & 15) * (13.287712379549449f / 16.f)); const float ang = pos * inv;
        float rev = ang * 0.15915494309189535f; rev -= floorf(rev);
        F_ROPE[t * 64 + j] = __builtin_amdgcn_cosf(rev); F_ROPE[t * 64 + 32 + j] = __builtin_amdgcn_sinf(rev); }
}
__device__ __forceinline__ void cs_gen(Frame& F) {
    const int gt = F.vcu * 512 + F.tid, NGT = F.G * 512;
    for (int i = gt; i < TL * 512; i += NGT) { const int k1 = i >> 9, c8 = (i & 511) * 8; const bool sn = c8 >= TL; const int t0 = c8 & (TL - 1);
        float v[8];
#pragma unroll
        for (int e = 0; e < 8; ++e) { const float fr = (float)((k1 * (t0 + e)) & (TL - 1)) * (1.f / 2048.f); v[e] = sn ? __builtin_amdgcn_sinf(fr) : __builtin_amdgcn_cosf(fr); }
        u32x4 o; o.x = pk2(v[0], v[1]); o.y = pk2(v[2], v[3]); o.z = pk2(v[4], v[5]); o.w = pk2(v[6], v[7]);
        *(u32x4*)(F_CS + (size_t)k1 * 4096 + c8) = o; }
}
__device__ __forceinline__ void prenorm_phase(Frame& F, const float* src_lat, const float* src_ctx, int nrows, const float* gain, const float* modl, int slot_sh, const float* pgate = nullptr, float pcoef = 0.f, int r0 = 0, size_t a_off = WS_A, size_t part_off = WS_PART) {
    const int gw = F.vcu * 8 + F.wave, NGW = F.G * 8, lane = F.lane;
    for (int r = r0 + gw; r < nrows; r += NGW) {
        const bool lat = r < NLAT; const float* xr = lat ? src_lat + (size_t)r * D : src_ctx + (size_t)(r - NLAT) * D; const int cond = lat ? (r >> 11) : 8;
        const float* sh = modl + (size_t)cond * (NMOD * D) + slot_sh * D; const float* sc = sh + D;
        f32x4 v[4]; float s = 0.f;
#pragma unroll
        for (int j = 0; j < 4; ++j) { v[j] = *(const f32x4*)(xr + 4 * lane + 256 * j);
            if (pgate && !lat) {
                const bf16_t* pp = (const bf16_t*)(F.ws + part_off) + (size_t)(r - NLAT) * D + 4 * lane + 256 * j; f32x4 a = (f32x4){0.f, 0.f, 0.f, 0.f};
#pragma unroll
                for (int q = 0; q < 8; ++q) { const u32x2 w = *(const u32x2*)(pp + (size_t)q * NCTX * D); a += (f32x4){bf2f(w.x & 0xffffu), bf2f(w.x >> 16), bf2f(w.y & 0xffffu), bf2f(w.y >> 16)}; }
                v[j] += a * (*(const f32x4*)(pgate + 4 * lane + 256 * j) * pcoef);
                *(f32x4*)(F_HC + (size_t)(r - NLAT) * D + 4 * lane + 256 * j) = v[j]; }
            s += (v[j][0] * v[j][0] + v[j][1] * v[j][1]) + (v[j][2] * v[j][2] + v[j][3] * v[j][3]); }
        const float rstd = rsqrtf(wave_sum(s) * (1.f / D) + EPS);
        bf16_t* orow = (bf16_t*)(F.ws + a_off) + (size_t)r * D;
#pragma unroll
        for (int j = 0; j < 4; ++j) { const int c0 = 4 * lane + 256 * j; const f32x4 g = *(const f32x4*)(gain + c0), a = *(const f32x4*)(sc + c0), b = *(const f32x4*)(sh + c0);
            const f32x4 y = (v[j] * rstd) * g * (a + 1.0f) + b; u32x2 o; o.x = pk2(y[0], y[1]); o.y = pk2(y[2], y[3]); *(u32x2*)(orow + c0) = o; }
    }
}
__device__ __forceinline__ void final_norm_phase(PRef p, Frame& F) {
    const int gw = F.vcu * 8 + F.wave, NGW = F.G * 8, lane = F.lane;
    for (int r = gw; r < NLAT; r += NGW) {
        float* xr = p.out + (size_t)r * D; f32x4 v[4]; float s = 0.f;
#pragma unroll
        for (int j = 0; j < 4; ++j) { v[j] = *(const f32x4*)(xr + 4 * lane + 256 * j); s += (v[j][0] * v[j][0] + v[j][1] * v[j][1]) + (v[j][2] * v[j][2] + v[j][3] * v[j][3]); }
        const float rstd = rsqrtf(wave_sum(s) * (1.f / D) + EPS);
#pragma unroll
        for (int j = 0; j < 4; ++j) { const int c0 = 4 * lane + 256 * j; const f32x4 g = *(const f32x4*)(p.final_norm + c0); *(f32x4*)(xr + c0) = (v[j] * rstd) * g; }
    }
}

__device__ __forceinline__ void gla_stream(PRef p, Frame& F, int sid) {
    const int tid = F.tid, lane = F.lane, w = F.wave, fr = lane & 15, fq = lane >> 4;
    const int dir = sid & 1, bh = sid >> 1, b = bh / 6, h = bh % 6;
    constexpr int SET = 4 * 64 * 72 + 128 * 72 - 64 * 72;
    LAS bf16_t* stg = (LAS bf16_t*)F.lds;
    LAS bf16_t* att = stg + 2 * SET;
    LAS bf16_t* Sb = att + 64 * 72;
    LAS float* ebl = (LAS float*)(Sb + 128 * 72);
    LAS float* gwl = ebl + 128;
    LAS float* gbl = gwl + 16 * 64;
    const bf16_t* z = F_ACT; const bf16_t* VT = F_VT + (size_t)(b * 768 + h * 128) * KVT; bf16_t* obuf = dir ? F_OB : F_OF;
    typedef const __attribute__((address_space(4))) f32x4 cf32x4;
    cf32x4* gwp = (cf32x4*)(unsigned long long)(p.gla_gate_w + (size_t)(dir * 16) * 384 + h * 64 + 8 * w); cf32x4* gbp = (cf32x4*)(unsigned long long)(p.gla_gate_b + dir * 384 + h * 64 + 8 * w);
    f32x4 st[4];
#pragma unroll
    for (int nb = 0; nb < 4; ++nb) st[nb] = (f32x4){0.f, 0.f, 0.f, 0.f};
    for (int i = tid; i < 128 * 72 / 2; i += 512) ((LAS unsigned*)Sb)[i] = 0u;
    u32x4 qraw, kraw, g0, g1, vraw[2];
#define GLA_ROW0(step_) (((step_) < 4) ? (size_t)NLAT + b * TC + 64 * (dir ? 3 - (step_) : (step_)) : (size_t)b * TL + 64 * (dir ? 35 - (step_) : (step_) - 4))
#define GLA_KV0(step_) (((step_) < 4) ? TL + 64 * (dir ? 3 - (step_) : (step_)) : 64 * (dir ? 35 - (step_) : (step_) - 4))
#define GLA_LOAD(step_) do { const bf16_t* zr_ = z + (GLA_ROW0(step_) + tk) * EV_LD; \
        qraw = *(const u32x4*)(zr_ + h * 64 + 8 * w); kraw = *(const u32x4*)(zr_ + 384 + h * 64 + 8 * w); \
        g0 = *(const u32x4*)(zr_ + 1536 + dir * 16); g1 = *(const u32x4*)(zr_ + 1536 + dir * 16 + 8); \
        const int kv0_ = GLA_KV0(step_); _Pragma("unroll") for (int i_ = 0; i_ < 2; ++i_) { const int id_ = tid + 512 * i_; vraw[i_] = *(const u32x4*)(VT + (size_t)(id_ >> 3) * KVT + kv0_ + (id_ & 7) * 8); } } while (0)
    const int tk = dir ? 63 - lane : lane;
    GLA_LOAD(0);
    __syncthreads();
    for (int step = 0; step < 36; ++step) {
        const size_t row0 = GLA_ROW0(step);
        LAS bf16_t* qd = stg + (step & 1) * SET; LAS bf16_t* kd = qd + 64 * 72; LAS bf16_t* kdT = kd + 64 * 72; LAS bf16_t* Vt = kdT + 64 * 72; LAS float* eb = ebl + (step & 1) * 64;
        float zg[16], q8[8], k8[8];
#pragma unroll
        for (int qq = 0; qq < 4; ++qq) { zg[2 * qq] = bf2f(g0[qq] & 0xffffu); zg[2 * qq + 1] = bf2f(g0[qq] >> 16); zg[8 + 2 * qq] = bf2f(g1[qq] & 0xffffu); zg[8 + 2 * qq + 1] = bf2f(g1[qq] >> 16);
            q8[2 * qq] = bf2f(qraw[qq] & 0xffffu); q8[2 * qq + 1] = bf2f(qraw[qq] >> 16); k8[2 * qq] = bf2f(kraw[qq] & 0xffffu); k8[2 * qq + 1] = bf2f(kraw[qq] >> 16); }
#pragma unroll
        for (int i = 0; i < 2; ++i) { const int id = tid + 512 * i; *(LAS u32x4*)(Vt + (id >> 3) * 72 + (id & 7) * 8) = vraw[i]; }
        if (step + 1 < 36) GLA_LOAD(step + 1);
        float lg[8];
        {
          { unsigned long long a_ = (unsigned long long)gwp, b_ = (unsigned long long)gbp; asm volatile("" : "+s"(a_), "+s"(b_)); gwp = (cf32x4*)a_; gbp = (cf32x4*)b_; }
          f32x4 x0 = gbp[0], x1 = gbp[1];
#pragma unroll
          for (int r = 0; r < 16; ++r) { const f32x4 w0 = gwp[r * 96], w1 = gwp[r * 96 + 1]; x0 += w0 * zg[r]; x1 += w1 * zg[r]; }
#pragma unroll
          for (int j = 0; j < 4; ++j) { lg[j] = (fminf(x0[j], 0.f) - __logf(1.f + __expf(-fabsf(x0[j])))) * (1.f / 16.f); lg[4 + j] = (fminf(x1[j], 0.f) - __logf(1.f + __expf(-fabsf(x1[j])))) * (1.f / 16.f); } }
#pragma unroll
        for (int j = 0; j < 8; ++j) { float x = lg[j];
            x += DPPF(x, 0x111, 0xf, 0xf); x += DPPF(x, 0x112, 0xf, 0xf); x += DPPF(x, 0x114, 0xf, 0xf); x += DPPF(x, 0x118, 0xf, 0xf);
            x += DPPF(x, 0x142, 0xa, 0xf); x += DPPF(x, 0x143, 0xc, 0xf); lg[j] = x; }
        float qo[8], ko[8], kc[8];
#pragma unroll
        for (int j = 0; j < 8; j += 2) {
            const float bl0 = __int_as_float(__builtin_amdgcn_readlane(__float_as_int(lg[j]), 63)), bl1 = __int_as_float(__builtin_amdgcn_readlane(__float_as_int(lg[j + 1]), 63));
            const f32x2_t qq = (f32x2_t){q8[j], q8[j + 1]} * 0.125f, kk = (f32x2_t){k8[j], k8[j + 1]};
            const f32x2_t e1 = (f32x2_t){__expf(lg[j]), __expf(lg[j + 1])}, e2 = (f32x2_t){__expf(-lg[j]), __expf(-lg[j + 1])}, e3 = (f32x2_t){__expf(bl0 - lg[j]), __expf(bl1 - lg[j + 1])};
            const f32x2_t a_ = qq * e1, b_ = kk * e2, c_ = kk * e3;
            qo[j] = a_.x; qo[j + 1] = a_.y; ko[j] = b_.x; ko[j + 1] = b_.y; kc[j] = c_.x; kc[j + 1] = c_.y;
            if (lane == 0) { eb[8 * w + j] = __expf(bl0); eb[8 * w + j + 1] = __expf(bl1); } }
        { u32x4 o; o.x = pk2(qo[0], qo[1]); o.y = pk2(qo[2], qo[3]); o.z = pk2(qo[4], qo[5]); o.w = pk2(qo[6], qo[7]); *(LAS u32x4*)(qd + tk * 72 + 8 * w) = o;
          o.x = pk2(ko[0], ko[1]); o.y = pk2(ko[2], ko[3]); o.z = pk2(ko[4], ko[5]); o.w = pk2(ko[6], ko[7]); *(LAS u32x4*)(kd + tk * 72 + 8 * w) = o; }
#pragma unroll
        for (int j = 0; j < 8; ++j) kdT[(8 * w + j) * 72 + tk] = (bf16_t)f2bf(kc[j]);
        __syncthreads();
        {
            const int ib = w >> 1, jb0 = 2 * (w & 1);
            const bf16x8 a0 = *(const LAS bf16x8*)(qd + (16 * ib + fr) * 72 + fq * 8), a1 = *(const LAS bf16x8*)(qd + (16 * ib + fr) * 72 + 32 + fq * 8);
#pragma unroll
            for (int jj = 0; jj < 2; ++jj) { const int jb = jb0 + jj;
                const bf16x8 b0 = *(const LAS bf16x8*)(kd + (16 * jb + fr) * 72 + fq * 8), b1 = *(const LAS bf16x8*)(kd + (16 * jb + fr) * 72 + 32 + fq * 8);
                f32x4 cc = (f32x4){0.f, 0.f, 0.f, 0.f}; cc = MFMA16(a0, b0, cc); cc = MFMA16(a1, b1, cc);
#pragma unroll
                for (int e = 0; e < 4; ++e) { const int i = 16 * ib + 4 * fq + e, j = 16 * jb + fr; const bool keep = dir ? (j >= i) : (j <= i); att[i * 72 + j] = (bf16_t)f2bf(keep ? cc[e] : 0.f); } }
        }
        __syncthreads();
        {
            const bf16x8 sA0 = *(const LAS bf16x8*)(Sb + (16 * w + fr) * 72 + fq * 8), sA1 = *(const LAS bf16x8*)(Sb + (16 * w + fr) * 72 + 32 + fq * 8);
            const bf16x8 vA0 = *(const LAS bf16x8*)(Vt + (16 * w + fr) * 72 + fq * 8), vA1 = *(const LAS bf16x8*)(Vt + (16 * w + fr) * 72 + 32 + fq * 8);
#pragma unroll
            for (int ib = 0; ib < 4; ++ib) {
                const bf16x8 q0 = *(const LAS bf16x8*)(qd + (16 * ib + fr) * 72 + fq * 8), q1 = *(const LAS bf16x8*)(qd + (16 * ib + fr) * 72 + 32 + fq * 8);
                const bf16x8 t0 = *(const LAS bf16x8*)(att + (16 * ib + fr) * 72 + fq * 8), t1 = *(const LAS bf16x8*)(att + (16 * ib + fr) * 72 + 32 + fq * 8);
                f32x4 cc = (f32x4){0.f, 0.f, 0.f, 0.f}; cc = MFMA16(sA0, q0, cc); cc = MFMA16(sA1, q1, cc); cc = MFMA16(vA0, t0, cc); cc = MFMA16(vA1, t1, cc);
                u32x2 o; o.x = pk2(cc[0], cc[1]); o.y = pk2(cc[2], cc[3]);
                *(u32x2*)(obuf + (row0 + 16 * ib + fr) * 768 + h * 128 + 16 * w + 4 * fq) = o;
            }
#pragma unroll
            for (int nb = 0; nb < 4; ++nb) {
                const float dcy = eb[16 * nb + fr]; st[nb] = st[nb] * dcy;
                const bf16x8 k0 = *(const LAS bf16x8*)(kdT + (16 * nb + fr) * 72 + fq * 8), k1 = *(const LAS bf16x8*)(kdT + (16 * nb + fr) * 72 + 32 + fq * 8);
                st[nb] = MFMA16(vA0, k0, st[nb]); st[nb] = MFMA16(vA1, k1, st[nb]);
#pragma unroll
                for (int e = 0; e < 4; ++e) Sb[(16 * w + 4 * fq + e) * 72 + 16 * nb + fr] = (bf16_t)f2bf(st[nb][e]);
            }
        }
    }
#undef GLA_LOAD
#undef GLA_ROW0
#undef GLA_KV0
    __syncthreads();
}
__device__ __forceinline__ void combine_phase(PRef p, Frame& F) {
    const int gw = F.vcu * 8 + F.wave, NGW = F.G * 8, lane = F.lane;
    for (int r = gw; r < NROW; r += NGW) {
#pragma unroll
        for (int it = 0; it < 3; ++it) {
            const int idx = it * 256 + lane * 4;
            const u32x2 a = *(const u32x2*)(F_OF + (size_t)r * 768 + idx), bq = *(const u32x2*)(F_OB + (size_t)r * 768 + idx), zr = *(const u32x2*)(F_ACT + (size_t)r * EV_LD + 768 + idx);
            float v[4] = {bf2f(a.x & 0xffffu) + bf2f(bq.x & 0xffffu), bf2f(a.x >> 16) + bf2f(bq.x >> 16), bf2f(a.y & 0xffffu) + bf2f(bq.y & 0xffffu), bf2f(a.y >> 16) + bf2f(bq.y >> 16)};
            float ss = (v[0] * v[0] + v[1] * v[1]) + (v[2] * v[2] + v[3] * v[3]);
#pragma unroll
            for (int o = 1; o < 32; o <<= 1) ss += __shfl_xor(ss, o);
            const float rstd = rsqrtf(ss * (1.f / 128.f) + EPS);
            const f32x4 g = *(const f32x4*)(p.gla_norm + (idx & 127));
            const float z0 = bf2f(zr.x & 0xffffu), z1 = bf2f(zr.x >> 16), z2 = bf2f(zr.y & 0xffffu), z3 = bf2f(zr.y >> 16);
            u32x2 o; o.x = pk2(v[0] * rstd * g[0] * silu_f(z0), v[1] * rstd * g[1] * silu_f(z1)); o.y = pk2(v[2] * rstd * g[2] * silu_f(z2), v[3] * rstd * g[3] * silu_f(z3));
            *(u32x2*)(F_ABUF + (size_t)r * D + 256 + idx) = o;
        }
    }
}

__device__ __forceinline__ void conv_part(PRef p, Frame& F) {
    const int gt = F.vcu * 512 + F.tid, NGT = F.G * 512; const bf16_t* z = F_ACT;
    for (int i = gt; i < NLAT * 32; i += NGT) {
        const int row = i >> 5, c8 = (i & 31) * 8, t = row & (TL - 1);
        const bf16_t* zr = z + (size_t)row * OD_LD;
        const u32x4 zb = *(const u32x4*)(zr + c8), c1 = *(const u32x4*)(zr + 256 + c8), x1 = *(const u32x4*)(zr + 512 + c8);
        u32x4 c0 = (u32x4){0u, 0u, 0u, 0u}, x0 = c0, c2 = c0, x2 = c0;
        if (t > 0) { c0 = *(const u32x4*)(zr - OD_LD + 256 + c8); x0 = *(const u32x4*)(zr - OD_LD + 512 + c8); }
        if (t < TL - 1) { c2 = *(const u32x4*)(zr + OD_LD + 256 + c8); x2 = *(const u32x4*)(zr + OD_LD + 512 + c8); }
        float o[8];
#pragma unroll
        for (int q = 0; q < 4; ++q)
#pragma unroll
            for (int hh = 0; hh < 2; ++hh) {
                const int c = c8 + 2 * q + hh;
                const float u0 = (hh ? bf2f(c0[q] >> 16) : bf2f(c0[q] & 0xffffu)) * (hh ? bf2f(x0[q] >> 16) : bf2f(x0[q] & 0xffffu));
                const float u1 = (hh ? bf2f(c1[q] >> 16) : bf2f(c1[q] & 0xffffu)) * (hh ? bf2f(x1[q] >> 16) : bf2f(x1[q] & 0xffffu));
                const float u2 = (hh ? bf2f(c2[q] >> 16) : bf2f(c2[q] & 0xffffu)) * (hh ? bf2f(x2[q] >> 16) : bf2f(x2[q] & 0xffffu));
                const float zbv = hh ? bf2f(zb[q] >> 16) : bf2f(zb[q] & 0xffffu);
                o[2 * q + hh] = zbv * (u0 * p.conv_w[c] + u1 * p.conv_w[256 + c] + u2 * p.conv_w[512 + c] + p.conv_b[c]);
            }
        u32x4 w; w.x = pk2(o[0], o[1]); w.y = pk2(o[2], o[3]); w.z = pk2(o[4], o[5]); w.w = pk2(o[6], o[7]);
        *(u32x4*)(F_ABUF + (size_t)row * D + c8) = w;
    }
}
__device__ __forceinline__ void attn_unit(PRef p, Frame& F, int unit, float lam) {
    const int tid = F.tid, lane = F.lane, w = F.wave, r32 = lane & 31, hi = lane >> 5, s = w >> 2, qw = w & 3;
    const int bh = unit >> 4, qh = unit & 15, b = bh / 6, h = bh % 6, q0 = qh * 128;
    constexpr int KROW = 272, VROW = 136, KBUF = 64 * KROW, VBUF = 128 * VROW, VOFF = 2 * KBUF;
    const bf16_t* z = F_ACT; const bf16_t* VT = F_VT + (size_t)(b * 768 + h * 128) * KVT;
    const size_t qrow = (size_t)b * TL + q0 + 32 * qw + r32;
    bf16x8 qr[4];
#pragma unroll
    for (int d0 = 0; d0 < 4; ++d0) qr[d0] = *(const bf16x8*)(z + qrow * OD_LD + 768 + h * 128 + s * 64 + d0 * 16 + hi * 8);
    int kr[2], kc[2], vr[2], vc[2];
#pragma unroll
    for (int i = 0; i < 2; ++i) { const int id = tid + 512 * i; kr[i] = id >> 4; kc[i] = id & 15; vr[i] = id >> 3; vc[i] = id & 7; }
    u32x4 kreg[2], vreg[2];
    const char* kbase_lat = (const char*)(z + ((size_t)b * TL) * OD_LD + 1536 + h * 128); const char* kbase_ctx = (const char*)(z + ((size_t)NLAT + (size_t)b * TC) * OD_LD + 1536 + h * 128);
    unsigned koffb[2], voffb[2];
#pragma unroll
    for (int i = 0; i < 2; ++i) { koffb[i] = (unsigned)(kr[i] * OD_LD + kc[i] * 8) * 2u; voffb[i] = (unsigned)(vr[i] * KVT + vc[i] * 8) * 2u; }
#define ATT_LOADK(t) do { const char* kb_ = (t) < 32 ? kbase_lat + (size_t)(t) * (64 * OD_LD * 2) : kbase_ctx + (size_t)((t) - 32) * (64 * OD_LD * 2); \
        _Pragma("unroll") for (int i = 0; i < 2; ++i) kreg[i] = *(const u32x4*)(kb_ + koffb[i]); } while (0)
#define ATT_LOADV(t) do { const char* vb_ = (const char*)VT + (size_t)(t) * 128; _Pragma("unroll") for (int i = 0; i < 2; ++i) vreg[i] = *(const u32x4*)(vb_ + voffb[i]); } while (0)
#define ATT_STOREK(buf) do { _Pragma("unroll") for (int i = 0; i < 2; ++i) *(LAS u32x4*)(F.lds + (buf) * KBUF + kr[i] * KROW + kc[i] * 16) = kreg[i]; } while (0)
#define ATT_STOREV(buf) do { _Pragma("unroll") for (int i = 0; i < 2; ++i) { \
        *(LAS u32x2*)(F.lds + VOFF + (buf) * VBUF + vr[i] * VROW + vc[i] * 16) = (u32x2){vreg[i].x, vreg[i].y}; \
        *(LAS u32x2*)(F.lds + VOFF + (buf) * VBUF + vr[i] * VROW + vc[i] * 16 + 8) = (u32x2){vreg[i].z, vreg[i].w}; } } while (0)
#define SB() do {} while (0)
#define Z16 ((f32x16){0.f, 0.f, 0.f, 0.f, 0.f, 0.f, 0.f, 0.f, 0.f, 0.f, 0.f, 0.f, 0.f, 0.f, 0.f, 0.f})
#define ATT_QK(kb_) do { const LAS unsigned char* Kb = F.lds + (kb_) * KBUF + r32 * KROW + (s * 64 + hi * 8) * 2; \
        _Pragma("unroll") for (int d0 = 0; d0 < 4; ++d0) { \
            const bf16x8 a0 = *(const LAS bf16x8*)(Kb + d0 * 32), a1 = *(const LAS bf16x8*)(Kb + 32 * KROW + d0 * 32); \
            if (d0 == 0) { p0 = MFMA32(a0, qr[0], Z16); p1 = MFMA32(a1, qr[0], Z16); } else { p0 = MFMA32(a0, qr[d0], p0); p1 = MFMA32(a1, qr[d0], p1); } } } while (0)
#define ATT_PVG(kb, ks) do { _Pragma("unroll") for (int nb = 0; nb < 4; ++nb) { \
            const LAS unsigned char* vp = Vb + nb * 32 * VROW + ((kb) * 32 + (ks) * 16) * 2; \
            const s16x4 lo = *(const LAS s16x4*)(vp), hh = *(const LAS s16x4*)(vp + 16); \
            const bf16x8 af = (bf16x8){lo[0], lo[1], lo[2], lo[3], hh[0], hh[1], hh[2], hh[3]}; \
            o[nb] = MFMA32(af, __builtin_bit_cast(bf16x8, pf[kb][ks]), o[nb]); } } while (0)
#define ATT_MAX8(P, B) fmaxf(fmaxf(fmaxf(fmaxf(fmaxf(fmaxf(fmaxf(P[B], P[B + 1]), P[B + 2]), P[B + 3]), P[B + 4]), P[B + 5]), P[B + 6]), P[B + 7])
#define ATT_EXP8(P, B, DST) do { _Pragma("unroll") for (int r = 0; r < 8; r += 2) {   \
            const f32x2_t d_ = (f32x2_t){P[B + r], P[B + r + 1]} - (f32x2_t){m_run, m_run}; \
            const f32x2_t e_ = (f32x2_t){__builtin_amdgcn_exp2f(d_.x), __builtin_amdgcn_exp2f(d_.y)}; rs2 += e_; P[B + r] = e_.x; P[B + r + 1] = e_.y; } \
        DST = (u32x4){cvt_pk_bf16(P[B], P[B + 1]), cvt_pk_bf16(P[B + 2], P[B + 3]), cvt_pk_bf16(P[B + 4], P[B + 5]), cvt_pk_bf16(P[B + 6], P[B + 7])}; } while (0)
    f32x16 o[4];
#pragma unroll
    for (int nb = 0; nb < 4; ++nb)
#pragma unroll
        for (int r = 0; r < 16; ++r) o[nb][r] = 0.f;
    float m_run = 0.f, l_run = 0.f;
    u32x4 pf[2][2]; f32x16 p0, p1;
    constexpr int NT = KVT / 64;
    ATT_LOADK(0); ATT_LOADV(0); ATT_STOREK(0); ATT_STOREV(0); ATT_LOADK(1); ATT_STOREK(1);
    __syncthreads();
    {
        ATT_QK(0);
        float mx = fmaxf(ATT_MAX8(p0, 0), ATT_MAX8(p0, 8)); mx = fmaxf(mx, fmaxf(ATT_MAX8(p1, 0), ATT_MAX8(p1, 8)));
        mx = fmaxf(mx, __shfl_xor(mx, 32)); m_run = mx;
        f32x2_t rs2 = (f32x2_t){0.f, 0.f};
        ATT_EXP8(p0, 0, pf[0][0]); ATT_EXP8(p0, 8, pf[0][1]); ATT_EXP8(p1, 0, pf[1][0]); ATT_EXP8(p1, 8, pf[1][1]);
        l_run = rs2.x + rs2.y;
    }
    __syncthreads();
    for (int t = 0; t < NT; ++t) {
        const bool more = t + 1 < NT;
        if (t + 2 < NT) ATT_LOADK(t + 2);
        if (more) ATT_LOADV(t + 1);
        const LAS unsigned char* Vb = F.lds + VOFF + (t & 1) * VBUF + r32 * VROW + hi * 8;
        if (more) {
            ATT_QK((t + 1) & 1);
            SB();
            ATT_PVG(0, 0);
            float mx = fmaxf(ATT_MAX8(p0, 0), ATT_MAX8(p0, 8));
            SB();
            ATT_PVG(0, 1);
            mx = fmaxf(mx, fmaxf(ATT_MAX8(p1, 0), ATT_MAX8(p1, 8)));
            mx = fmaxf(mx, __shfl_xor(mx, 32)) - m_run;
            const bool need = __any(mx > 8.0f);
            const float dl = need ? fmaxf(mx, 0.f) : 0.f; m_run += dl;
            const float alpha = __builtin_amdgcn_exp2f(-dl); l_run *= alpha;
            f32x2_t rs2 = (f32x2_t){0.f, 0.f};
            SB();
            ATT_PVG(1, 0);
            u32x4 n00, n01, n10, n11;
            ATT_EXP8(p0, 0, n00); ATT_EXP8(p0, 8, n01);
            SB();
            ATT_PVG(1, 1);
            ATT_EXP8(p1, 0, n10);
            SB();
            ATT_EXP8(p1, 8, n11);
            l_run += rs2.x + rs2.y;
            pf[0][0] = n00; pf[0][1] = n01; pf[1][0] = n10; pf[1][1] = n11;
            if (need) {
#pragma unroll
                for (int nb = 0; nb < 4; ++nb)
#pragma unroll
                    for (int r = 0; r < 16; ++r) o[nb][r] *= alpha;
            }
        } else {
            ATT_PVG(0, 0); ATT_PVG(0, 1); ATT_PVG(1, 0); ATT_PVG(1, 1);
        }
        if (t + 2 < NT) ATT_STOREK(t & 1);
        if (more) ATT_STOREV((t + 1) & 1);
        __syncthreads();
    }
#undef ATT_LOADK
#undef ATT_LOADV
#undef ATT_STOREK
#undef ATT_STOREV
#undef ATT_QK
#undef ATT_PVG
#undef ATT_MAX8
#undef ATT_EXP8
#undef SB
#undef Z16
    l_run += __shfl_xor(l_run, 32);
    const float inv = 1.0f / l_run;
    LAS float* ex = (LAS float*)F.lds;
    if (s == 1) {
#pragma unroll
        for (int nb = 0; nb < 4; ++nb)
#pragma unroll
            for (int r = 0; r < 16; ++r) ex[(qw * 64 + nb * 16 + r) * 64 + lane] = o[nb][r] * inv;
    }
    __syncthreads();
    if (s == 0) {
        float ss = 0.f;
#pragma unroll
        for (int nb = 0; nb < 4; ++nb)
#pragma unroll
            for (int r = 0; r < 16; ++r) { const float y = o[nb][r] * inv - lam * ex[(qw * 64 + nb * 16 + r) * 64 + lane]; o[nb][r] = y; ss += y * y; }
        ss += __shfl_xor(ss, 32);
        const float rstd = rsqrtf(ss * (1.f / 128.f) + EPS) * (1.0f - LAM_INIT);
        bf16_t* orow = F_ABUF + qrow * D + 256 + h * 128;
#pragma unroll
        for (int nb = 0; nb < 4; ++nb)
#pragma unroll
            for (int rq = 0; rq < 4; ++rq) {
                const int dv = 32 * nb + 8 * rq + 4 * hi; const f32x4 g = *(const f32x4*)(p.diff_norm + dv);
                u32x2 ov; ov.x = pk2(o[nb][4 * rq] * rstd * g[0], o[nb][4 * rq + 1] * rstd * g[1]); ov.y = pk2(o[nb][4 * rq + 2] * rstd * g[2], o[nb][4 * rq + 3] * rstd * g[3]);
                *(u32x2*)(orow + dv) = ov;
            }
    }
    __syncthreads();
}

#define XB_TMO      128
#define XB_XCNT(j)  (256  + 64 * (j))
#define XB_XSUB(j)  (1280 + 64 * (j))
#define XB_XGEN(j)  (2304 + 64 * (j))
#define XB_TOP      3328
#define XB_TOPGEN   3392
#define XCD_BAR_WORDS 3456
#define XB_SPIN_CAP (1u << 18)

__device__ __forceinline__ unsigned xb_ld(unsigned* p)              { return __hip_atomic_load(p, __ATOMIC_RELAXED, __HIP_MEMORY_SCOPE_AGENT); }
__device__ __forceinline__ unsigned xb_add(unsigned* p, unsigned v) { return __hip_atomic_fetch_add(p, v, __ATOMIC_RELAXED, __HIP_MEMORY_SCOPE_AGENT); }
__device__ __forceinline__ unsigned xb_xcc_id() { return (unsigned)__builtin_amdgcn_s_getreg((3 << 11) | 20) & 0xFu; }
#define XB_SPIN(cond, bar) do { unsigned _sp = 0; while (cond) { __builtin_amdgcn_s_sleep(1); \
    if ((++_sp & 255u) == 0u) { if (xb_ld(&(bar)[XB_TMO])) break; if (_sp > XB_SPIN_CAP) { atomicAdd(&(bar)[XB_TMO], 1u); break; } } } } while (0)

struct XcdBarrier {
    unsigned* bar; unsigned x;
    volatile LAS unsigned* st;
};

__device__ __forceinline__ XcdBarrier xcd_barrier_post(unsigned* bar, volatile LAS unsigned* st, const bool t0) {
    XcdBarrier b; b.bar = bar; b.x = xb_xcc_id(); b.st = st;
    if (t0) (void)xb_add(&bar[XB_XCNT(b.x)], 1u);
    return b;
}
__device__ __forceinline__ void xcd_barrier_complete(unsigned* bar, unsigned x, unsigned& nloc, unsigned& nx) {
    const unsigned G = gridDim.x * gridDim.y * gridDim.z;
    unsigned sum, cnt, mine, sp = 0u;
    for (;;) {
        sum = 0u; cnt = 0u; mine = 0u;
#pragma unroll
        for (unsigned j = 0; j < 16; ++j) { const unsigned c = xb_ld(&bar[XB_XCNT(j)]); sum += c; cnt += (c > 0u) ? 1u : 0u; mine = (j == x) ? c : mine; }
        if (sum == G) break;
        __builtin_amdgcn_s_sleep(1);
        if ((++sp & 255u) == 0u) { if (xb_ld(&bar[XB_TMO])) break; if (sp > XB_SPIN_CAP) { atomicAdd(&bar[XB_TMO], 1u); break; } }
    }
    nloc = mine > 0u ? mine : 1u; nx = cnt > 0u ? cnt : 1u;
}

__device__ __forceinline__ void xcd_barrier(const XcdBarrier& b, const bool t0) {
    asm volatile("s_waitcnt vmcnt(0)" ::: "memory");
    __syncthreads();
    if (t0) {
        unsigned* bar = b.bar;
        __builtin_amdgcn_s_waitcnt(0);
        unsigned nloc = b.st[0], nx = b.st[1];
        if (nloc == 0u) { xcd_barrier_complete(bar, b.x, nloc, nx); b.st[0] = nloc; b.st[1] = nx; }
        const unsigned old = xb_add(&bar[XB_XSUB(b.x)], 1u);
        const unsigned gen = old / nloc;
        if (old + 1u == (gen + 1u) * nloc) {
            __builtin_amdgcn_fence(__ATOMIC_RELEASE, "agent");
            asm volatile("s_waitcnt vmcnt(0)" ::: "memory");
            const unsigned og = xb_add(&bar[XB_TOP], 1u);
            const unsigned tg = og / nx;
            if (og + 1u == (tg + 1u) * nx) xb_add(&bar[XB_TOPGEN], 1u);
            else XB_SPIN(xb_ld(&bar[XB_TOPGEN]) == tg, bar);
            __builtin_amdgcn_fence(__ATOMIC_ACQUIRE, "agent");
            xb_add(&bar[XB_XGEN(b.x)], 1u);
            asm volatile("s_waitcnt vmcnt(0)" ::: "memory");
        } else {
            XB_SPIN(xb_ld(&bar[XB_XGEN(b.x)]) == gen, bar);
            __builtin_amdgcn_fence(__ATOMIC_ACQUIRE, "agent");
            asm volatile("s_waitcnt vmcnt(0)" ::: "memory");
        }
    }
    __syncthreads();
}


template <int ph>
__device__ __forceinline__ void run_phase(PRef p, Frame& F) {
        if (ph == 0) { prep_phase(p, F); }
        else if (ph == 23) { final_norm_phase(p, F); }
        else {
            const int l = (ph - 1) / 11, q = (ph - 1) % 11;
            const unsigned wl = (unsigned)(WS_W0 + (size_t)l * W_LAYER);
            const float* modl = F_MOD + (size_t)l * 9 * (NMOD * D);
            const bool l0 = (l == 0);
            if (q == 0 || q == 3 || q == 8) {
                const float* sl = (l0 && q == 0) ? p.x : p.out; const float* sc = (l0 && q == 0) ? p.ctx : F_HC;
                const float* gain = (q == 0 ? p.norm_ffn1 : q == 3 ? p.norm_mix : p.norm_ffn2) + l * D;
                const int nrows = (!l0 && q == 8) ? NLAT : NROW;
                if (l0 && q == 3) cs_gen(F);
                const bool hasp = !(l0 && q == 0) && !(!l0 && q == 8);
                const float* pg = hasp ? (q == 0 ? F_MOD + 8 * D : modl + (q == 3 ? 2 : 5) * D) + (size_t)8 * (NMOD * D) : nullptr;
                const float* scx = (l0 && q == 3) ? p.ctx : sc;
                const int r0 = ((q == 3) || (q == 8) || (!l0 && q == 0)) ? NLAT : 0;
                prenorm_phase(F, sl, scx, nrows, gain, modl, q == 0 ? 0 : q == 3 ? 3 : 6, pg, (q == 8) ? 1.0f : 0.5f, r0, (q == 8) ? WS_A2 : WS_A, (q == 8) ? WS_ACT : WS_PART);
            } else if (q == 1 || q == 9 || q == 4 || (q == 5 && l0)) {
                pg8::Sched S; S.nfull = 0; S.parts = 1; S.kpart = 0; S.kbase = 0; S.pbase = 0; S.G = F.G; S.vcu = F.vcu; S.coff = 0; S.tstep = 256u * D * 2u; S.ws = (const char*)F.ws;
                const pg8::Seg none{0u, 0u, 0u}; S.s0 = none; S.s1 = none; S.s2 = none;
                pg8::EpiT E; E.ws = F.ws; E.dst_off = (unsigned)WS_ACT; E.ldc = FF;
                int K = D, ld = D, njob = 1;
                if (q == 1 || q == 9) {
                    const int nM = (!l0 && q == 9) ? 64 : 72;
                    S.s0 = pg8::mkseg((unsigned)((q == 9) ? WS_A2 : WS_A), wl + (unsigned)(q == 1 ? W_F1I : W_F2I), nM, 22, 0, 0, pg8::T_SWIGLU);
                    S.nfull = ((nM * 22) / 256) * 256;
                } else if (q == 4 && l0) {
                    E.ldc = EV_LD;
                    S.s0 = pg8::mkseg((unsigned)WS_A, (unsigned)WS_WEV, 72, 7, 0, 0, pg8::T_ZEV);
                    S.s1 = pg8::mkseg((unsigned)WS_WEVV, (unsigned)WS_A, 3, 72, 0, 0, pg8::T_TRV);
                    S.s2 = pg8::mkseg((unsigned)WS_WPQ, (unsigned)WS_A, 2, 72, 0, 0, pg8::T_TRPQ);
                    S.nfull = 768;
                } else if (q == 4) {
                    E.ldc = OD_LD;
                    S.s0 = pg8::mkseg((unsigned)WS_A, (unsigned)WS_WOD, 64, 9, 0, 0, pg8::T_ZODD);
                    S.s1 = pg8::mkseg((unsigned)WS_A, (unsigned)WS_WOD, 8, 3, 64, 6, pg8::T_ZODD);
                    S.s2 = pg8::mkseg((unsigned)WS_WODV, (unsigned)WS_A, 3, 72, 0, 0, pg8::T_TRV);
                    S.nfull = 768;
                } else {
                    E.dst_off = (unsigned)WS_A; E.ldc = D; njob = 2; K = 4096; ld = 4096; S.tstep = 256u * 4096u * 2u;
                    S.s0 = pg8::mkseg((unsigned)WS_CS, (unsigned)WS_PQT, 8, 8, 0, 0, pg8::T_FOUR);
                }
#pragma unroll 1
                for (int j = 0; j < njob; ++j) {
                    if (j == 1) { K = 512; ld = 512; S.coff = 64; S.tstep = 256u * 512u * 2u; S.s0 = pg8::mkseg((unsigned)WS_CSC, (unsigned)WS_PQTC, 1, 8, 0, 0, pg8::T_FOURC); S.s1 = none; }
                    if constexpr (q == 1 || q == 9 || q == 4) pg8::gemm_phase<pg8::EpiT, true>(F.lds, F.tid, K, ld, S, E); else pg8::gemm_phase<pg8::EpiT>(F.lds, F.tid, K, ld, S, E);
                }
                if (l0 && q == 1 && F.vcu >= 96) prep_items(p, F, 1, (F.vcu - 96) * 8 + F.wave, (F.G - 96) * 8);
                if (l0 && q == 5 && (F.vcu < 136 || F.vcu >= 232)) { const int wk = F.vcu < 136 ? F.vcu : 136 + (F.vcu - 232); prep_items(p, F, 3, wk * 8 + F.wave, 160 * 8); prep_items(p, F, 2, wk * 8 + F.wave, 160 * 8); }
                if (q == 5) { for (int sid = F.vcu - 136; sid >= 0 && sid < 96; sid += F.G) gla_stream(p, F, sid); }
            } else if (q == 2 || q == 10 || q == 7) {
                const bool first = l0 && q == 2;
                const bool ctxp = !(!l0 && q != 2);
                const int K = (q == 7) ? D : FF;
                pg8::Sched S; S.nfull = 0; S.parts = 1; S.kpart = 0; S.kbase = 0; S.pbase = 0; S.G = F.G; S.vcu = F.vcu; S.coff = 0; S.tstep = 256u * (unsigned)K * 2u; S.ws = (const char*)F.ws;
                const pg8::Seg none{0u, 0u, 0u}; S.s1 = none; S.s2 = none;
                const unsigned Aoff = (unsigned)(q == 7 ? WS_A : WS_ACT), Boff = wl + (unsigned)(q == 2 ? W_F1O : q == 10 ? W_F2O : W_MO);
                S.s0 = pg8::mkseg(Aoff, Boff, 64, 4, 0, 0, 0);
                if constexpr (!l0 && (q == 7 || q == 10)) {
                    const pg8::EpiRN E{p.out, modl + (q == 7 ? 5 : 8) * D, p.out, p.final_norm, p.out, (bf16_t*)(F.ws + WS_A2), p.norm_ffn2 + l * D, modl + 6 * D,
                                       (float*)(F.ws + WS_XBUF) + (q == 7 ? 0 : NLAT * 4), (unsigned*)(F.ws + WS_XCNT) + (q == 7 ? 0 : 64 * 64), (q == 7) ? 1.0f : 0.5f, (q == 7) ? 1 : 0};
                    pg8::gemm_phase<pg8::EpiRN>(F.lds, F.tid, K, K, S, E);
                } else if constexpr (l0 && q == 7) {
                    const pg8::EpiRN E{p.out, modl + 5 * D, p.out, p.final_norm, p.out, (bf16_t*)(F.ws + WS_A2), p.norm_ffn2, modl + 6 * D,
                                       (float*)(F.ws + WS_XBUF) + NLAT * 4, (unsigned*)(F.ws + WS_XCNT) + 5 * 64 * 64, 1.0f, 1};
                    pg8::gemm_phase<pg8::EpiRN>(F.lds, F.tid, K, K, S, E);
                } else if constexpr (q == 2 || (l0 && q == 10)) {
                    constexpr int site = l0 ? (q == 2 ? 2 : 3) : 4;
                    const float* ngain = (q == 2) ? p.norm_mix + l * D : p.norm_ffn1 + D;
                    const float* nscsh = (q == 2) ? modl + 3 * D : F_MOD + (size_t)9 * (NMOD * D);
                    const pg8::EpiRN E{first ? p.x : p.out, modl + (q == 2 ? 2 : 8) * D, p.out, p.final_norm, p.out, (bf16_t*)(F.ws + WS_A), ngain, nscsh,
                                       (float*)(F.ws + WS_XBUF) + (site & 1) * NLAT * 4, (unsigned*)(F.ws + WS_XCNT) + site * 64 * 64, 0.5f, 1};
                    pg8::gemm_phase<pg8::EpiRN>(F.lds, F.tid, K, K, S, E);
                } else {
                pg8::EpiR E; E.in_lat = first ? p.x : p.out; E.in_ctx = first ? p.ctx : F_HC; E.out_lat = p.out; E.out_ctx = F_HC;
                E.gate = modl + (q == 2 ? 2 : q == 7 ? 5 : 8) * D; E.coef = (q == 7) ? 1.0f : 0.5f;
                pg8::gemm_phase<pg8::EpiR>(F.lds, F.tid, K, K, S, E);
                }
                if (ctxp) {
                    const pg8::EpiP EP{(bf16_t*)(F.ws + ((l0 && q == 7) ? WS_ACT : WS_PART))};
                    S.s0 = pg8::mkseg(Aoff, Boff, 8, 4, 64, 0, 0);
                    const bool j0 = F.vcu < 192;
                    if (q == 7) { S.parts = 8; S.kpart = 128; }
                    else { S.parts = j0 ? 6 : 2; S.kpart = j0 ? 384 : 256; S.kbase = j0 ? 0 : 2304; S.pbase = j0 ? 0 : 6; S.coff = j0 ? 0 : 192; }
                    pg8::gemm_phase<pg8::EpiP>(F.lds, F.tid, S.kpart, K, S, EP);
                }
            } else if (q == 5) {
                float a1 = p.lq1[F.lane] * p.lk1[F.lane], a2 = p.lq2[F.lane] * p.lk2[F.lane];
                a1 = wave_sum(a1); a2 = wave_sum(a2);
                const float lam = __expf(a1) - __expf(a2) + LAM_INIT;
                conv_part(p, F);
                for (int u = F.vcu; u < 768; u += F.G) attn_unit(p, F, u, lam);
            } else if (q == 6) {
                if (l0) combine_phase(p, F);
            }
        }
}

__global__ void __launch_bounds__(512, 2) fwd_kernel(Params p_arg) {
    extern __shared__ __attribute__((aligned(16))) unsigned char lds_raw[];
    cg::grid_group grid = cg::this_grid();
    volatile LAS unsigned* st_ = (volatile LAS unsigned*)((LAS unsigned char*)lds_raw + 131072);
    const int wave_s = __builtin_amdgcn_readfirstlane(threadIdx.x >> 6);
    if (threadIdx.x < 4) st_[threadIdx.x] = 0u;
    __syncthreads();
    if (p_arg.ph_lo < 0) grid.sync();
    XcdBarrier bar = xcd_barrier_post((unsigned*)(p_arg.ws + WS_BAR), st_, (wave_s == 0) && (__builtin_amdgcn_mbcnt_hi(~0u, __builtin_amdgcn_mbcnt_lo(~0u, 0u)) == 0));
#define RUN_PHASE(k) { \
        KParams* kp_ = (KParams*)__builtin_amdgcn_kernarg_segment_ptr(); asm volatile("" : "+s"(kp_)); PRef p = *kp_; \
        Frame F; F.lds = (LAS unsigned char*)lds_raw; \
        int w_ = wave_s; asm volatile("" : "+s"(w_)); int l_ = __builtin_amdgcn_mbcnt_hi(~0u, __builtin_amdgcn_mbcnt_lo(~0u, 0u)); asm volatile("" : "+v"(l_)); F.lane = l_; F.wave = w_; F.tid = w_ * 64 + l_; \
        int g_ = gridDim.x, bx_ = blockIdx.x; asm volatile("" : "+s"(g_), "+s"(bx_)); F.G = g_; F.vcu = (g_ % 8 == 0) ? (bx_ % 8) * (g_ / 8) + bx_ / 8 : bx_; \
        F.ws = p.ws; \
        run_phase<(k)>(p, F); }
#define SEAM() xcd_barrier(bar, (wave_s == 0) && (__builtin_amdgcn_mbcnt_hi(~0u, __builtin_amdgcn_mbcnt_lo(~0u, 0u)) == 0))
    RUN_PHASE(0) SEAM();
    RUN_PHASE(1) SEAM(); RUN_PHASE(2) SEAM(); RUN_PHASE(3) SEAM(); RUN_PHASE(4) SEAM(); RUN_PHASE(5) SEAM(); RUN_PHASE(6) SEAM(); RUN_PHASE(7) SEAM(); RUN_PHASE(8) SEAM();
    RUN_PHASE(9) SEAM(); RUN_PHASE(10) SEAM(); RUN_PHASE(11) SEAM(); RUN_PHASE(12) SEAM(); RUN_PHASE(13) SEAM(); RUN_PHASE(14) SEAM(); RUN_PHASE(15) SEAM(); RUN_PHASE(16) SEAM();
    RUN_PHASE(17) SEAM(); RUN_PHASE(19) SEAM(); RUN_PHASE(21) SEAM(); RUN_PHASE(22)
#undef RUN_PHASE
#undef SEAM
}

extern "C" void kernel_launch(void* const* d_in, const int* in_sizes, int n_in, void* d_out, int out_size, void* d_ws, size_t ws_size, hipStream_t stream) {
    static int grid_blocks = 0;
    if (grid_blocks == 0) {
        if (n_in != 27 || out_size != NLAT * D || ws_size < WS_END) { fprintf(stderr, "kernel_launch: unexpected problem (n_in %d out %d ws %zu, need %zu)\n", n_in, out_size, ws_size, (size_t)WS_END); grid_blocks = -1; return; }
        int dev = 0, cus = 0, per_cu = 0;
        hipGetDevice(&dev);
        hipDeviceGetAttribute(&cus, hipDeviceAttributeMultiprocessorCount, dev);
        hipFuncSetAttribute((const void*)fwd_kernel, hipFuncAttributeMaxDynamicSharedMemorySize, LDS_BYTES);
        hipOccupancyMaxActiveBlocksPerMultiprocessor(&per_cu, (const void*)fwd_kernel, 512, LDS_BYTES);
        if (per_cu < 1) { fprintf(stderr, "kernel_launch: occupancy query reports %d blocks per CU\n", per_cu); grid_blocks = -1; return; }
        grid_blocks = cus;
        if (grid_blocks < 256) { fprintf(stderr, "kernel_launch: needs >= 256 CUs, got %d\n", grid_blocks); grid_blocks = -1; return; }
    }
    if (grid_blocks < 0) return;
    if (hipMemsetAsync((char*)d_ws + WS_BAR, 0, (WS_XCNT - WS_BAR) + 6 * 64 * 256, stream) != hipSuccess) { fprintf(stderr, "kernel_launch: memset of the barrier words failed\n"); return; }
    Params p{};
    const float** pp = (const float**)&p;
    for (int i = 0; i < 27; ++i) pp[i] = (const float*)d_in[i];
    p.out = (float*)d_out; p.ws = (unsigned char*)d_ws; p.ph_lo = 0; p.ph_hi = 24;
    void* args[] = {&p};
    hipError_t e = hipLaunchCooperativeKernel((const void*)fwd_kernel, dim3(grid_blocks), dim3(512), args, LDS_BYTES, stream);
    if (e != hipSuccess) fprintf(stderr, "cooperative launch failed: %s (grid %d)\n", hipGetErrorString(e), grid_blocks);
}
```
